# Optimizing an MI355X kernel written in HIP

```python
import jax, jax.numpy as jnp
from jax import lax
import numpy as np

D_MODEL = 1024
BATCH = 8
SEQ = 8192
DEPTH = 1
DEC_BATCH = 8
DEC_SEQ = 32
PAST_LEN = 1024

CHUNK = 64
D_LRU = 512
LRU_HEADS = 8
LRU_HEAD_DIM = D_LRU // LRU_HEADS
CONV_W = 4
LRU_C = 8.0
D_SG = 512
SG_GROUPS = 4
SG_GROUP_DIM = D_SG // SG_GROUPS
SG_LEN = 128
D_MIX = D_LRU + D_SG
D_IN = 2 * D_LRU + 2 * D_SG
D_FF = 2816
N_MOD = 9
ALPHA = (2 * DEPTH) ** 0.25
BETA = (8 * DEPTH) ** -0.25
LN_EPS = 1e-5

kernel_name = "hybrid_rglru_gmlp_streaming_step"


def layer_norm(x, g, b):
    xf = x.astype(jnp.float32)
    mu = jnp.mean(xf, axis=-1, keepdims=True)
    xc = xf - mu
    var = jnp.mean(xc * xc, axis=-1, keepdims=True)
    return (xc * lax.rsqrt(var + LN_EPS) * g.astype(jnp.float32) + b.astype(jnp.float32)).astype(x.dtype)


def swiglu(h, w1, w3, w2):
    return (jax.nn.silu(h @ w1) * (h @ w3)) @ w2


def causal_conv(x, hist, w, b):
    T = x.shape[1]
    xp = jnp.concatenate([hist.astype(x.dtype), x], axis=1)
    y = sum((w[k] * xp[:, k:k + T] for k in range(CONV_W)), b)
    return y, xp[:, -(CONV_W - 1):]


def rg_lru(x, h0, w_a, b_a, w_x, b_x, lam):
    B, T, _ = x.shape
    xh = x.reshape(B, T, LRU_HEADS, LRU_HEAD_DIM)
    r = jax.nn.sigmoid(jnp.einsum('bthi,hij->bthj', xh, w_a).reshape(B, T, D_LRU) + b_a)
    i = jax.nn.sigmoid(jnp.einsum('bthi,hij->bthj', xh, w_x).reshape(B, T, D_LRU) + b_x)
    log_a = -LRU_C * r.astype(jnp.float32) * jax.nn.softplus(-lam.astype(jnp.float32))
    a = jnp.exp(log_a)
    u = jnp.sqrt(-jnp.expm1(2.0 * log_a)) * (i * x).astype(jnp.float32)

    def combine(left, right):
        a1, b1 = left
        a2, b2 = right
        return a1 * a2, a2 * b1 + b2

    a_cum, h_cum = lax.associative_scan(combine, (a, u), axis=1)
    h = h_cum + a_cum * h0[:, None, :].astype(jnp.float32)
    return h.astype(x.dtype), h[:, -1].astype(x.dtype)


def spatial_gate(u, v, w_s, b_s):
    B, T, _ = v.shape
    n = -(-T // SG_LEN)
    pad = n * SG_LEN - T
    vp = jnp.pad(v, ((0, 0), (0, pad), (0, 0))).reshape(B, n, SG_LEN, SG_GROUPS, SG_GROUP_DIM)
    mask = jnp.tril(jnp.ones((SG_LEN, SG_LEN), dtype=bool))
    w = jnp.where(mask[None], w_s, jnp.zeros_like(w_s))
    z = jnp.einsum('gij,bcjgd->bcigd', w, vp) + jnp.transpose(b_s)[None, None, :, :, None]
    z = z.reshape(B, n * SG_LEN, D_SG)[:, :T]
    return u * z


def layer(x, c, conv_hist, h0, w_ada, b_ada, ln_g, ln_b,
          ffn1_w1, ffn1_w3, ffn1_w2, ffn2_w1, ffn2_w3, ffn2_w2,
          w_in, w_out, conv_w, conv_b, lru_wa, lru_ba, lru_wx, lru_bx, lru_lambda,
          sg_ln_g, sg_ln_b, sg_w, sg_b):
    B = x.shape[0]
    mod = (jax.nn.silu(c) @ w_ada + b_ada).reshape(B, N_MOD, D_MODEL)[:, None]

    def modulate(h, k):
        return h * (1.0 + mod[:, :, 3 * k + 1]) + mod[:, :, 3 * k]

    def gate(k):
        return 1.0 + mod[:, :, 3 * k + 2]

    f = swiglu(modulate(x, 0), ffn1_w1, ffn1_w3, ffn1_w2)
    x = layer_norm(ALPHA * x + 0.5 * gate(0) * f, ln_g[0], ln_b[0])

    proj = modulate(x, 1) @ w_in
    xa, ga, us, vs = jnp.split(proj, [D_LRU, 2 * D_LRU, 2 * D_LRU + D_SG], axis=-1)
    xc, new_hist = causal_conv(xa, conv_hist, conv_w, conv_b)
    hl, h_last = rg_lru(xc, h0, lru_wa, lru_ba, lru_wx, lru_bx, lru_lambda)
    ya = hl * jax.nn.gelu(ga)
    vn = layer_norm(vs, sg_ln_g, sg_ln_b)
    yb = spatial_gate(us, vn, sg_w, sg_b)
    m = jnp.concatenate([ya, yb], axis=-1) @ w_out
    x = layer_norm(ALPHA * x + gate(1) * m, ln_g[1], ln_b[1])

    f = swiglu(modulate(x, 2), ffn2_w1, ffn2_w3, ffn2_w2)
    x = layer_norm(ALPHA * x + 0.5 * gate(2) * f, ln_g[2], ln_b[2])
    return x, new_hist, h_last, vn


def setup_inputs(seed: int = 0) -> dict:
    key = jax.random.key(seed)
    ks = iter(jax.random.split(key, 40))
    nrm = lambda shape, s: jax.random.normal(next(ks), shape, jnp.float32) * s
    a0 = jax.random.uniform(next(ks), (DEPTH, D_LRU), jnp.float32, 0.9, 0.999)
    sig = a0 ** (1.0 / LRU_C)
    lru_lambda = jnp.log(sig) - jnp.log1p(-sig)
    return {
        "x_prompt": nrm((BATCH, SEQ, D_MODEL), 1.0),
        "x_sample": nrm((DEC_BATCH, DEC_SEQ, D_MODEL), 1.0),
        "c_prompt": nrm((BATCH, D_MODEL), 1.0),
        "c_sample": nrm((DEC_BATCH, D_MODEL), 1.0),
        "state_conv": nrm((DEPTH, DEC_BATCH, CONV_W - 1, D_LRU), 1.0),
        "state_lru": nrm((DEPTH, DEC_BATCH, D_LRU), 0.5),
        "ln_in_g": 1.0 + nrm((D_MODEL,), 0.02),
        "ln_in_b": nrm((D_MODEL,), 0.02),
        "w_ada": nrm((DEPTH, D_MODEL, N_MOD * D_MODEL), 0.2 * D_MODEL ** -0.5),
        "b_ada": nrm((DEPTH, N_MOD * D_MODEL), 0.02),
        "ln_g": 1.0 + nrm((DEPTH, 3, D_MODEL), 0.02),
        "ln_b": nrm((DEPTH, 3, D_MODEL), 0.02),
        "ffn1_w1": nrm((DEPTH, D_MODEL, D_FF), BETA * D_MODEL ** -0.5),
        "ffn1_w3": nrm((DEPTH, D_MODEL, D_FF), BETA * D_MODEL ** -0.5),
        "ffn1_w2": nrm((DEPTH, D_FF, D_MODEL), BETA * D_FF ** -0.5),
        "ffn2_w1": nrm((DEPTH, D_MODEL, D_FF), BETA * D_MODEL ** -0.5),
        "ffn2_w3": nrm((DEPTH, D_MODEL, D_FF), BETA * D_MODEL ** -0.5),
        "ffn2_w2": nrm((DEPTH, D_FF, D_MODEL), BETA * D_FF ** -0.5),
        "w_in": nrm((DEPTH, D_MODEL, D_IN), D_MODEL ** -0.5),
        "w_out": nrm((DEPTH, D_MIX, D_MODEL), BETA * D_MIX ** -0.5),
        "conv_w": nrm((DEPTH, CONV_W, D_LRU), CONV_W ** -0.5),
        "conv_b": nrm((DEPTH, D_LRU), 0.02),
        "lru_wa": nrm((DEPTH, LRU_HEADS, LRU_HEAD_DIM, LRU_HEAD_DIM), LRU_HEAD_DIM ** -0.5),
        "lru_ba": nrm((DEPTH, D_LRU), 0.02),
        "lru_wx": nrm((DEPTH, LRU_HEADS, LRU_HEAD_DIM, LRU_HEAD_DIM), LRU_HEAD_DIM ** -0.5),
        "lru_bx": nrm((DEPTH, D_LRU), 0.02),
        "lru_lambda": lru_lambda,
        "sg_ln_g": 1.0 + nrm((DEPTH, D_SG), 0.02),
        "sg_ln_b": nrm((DEPTH, D_SG), 0.02),
        "sg_w": nrm((DEPTH, SG_GROUPS, SG_LEN, SG_LEN), SG_LEN ** -0.5),
        "sg_b": 1.0 + nrm((DEPTH, SG_GROUPS, SG_LEN), 0.02),
    }


def reference(x_prompt, x_sample, c_prompt, c_sample, state_conv, state_lru,
              ln_in_g, ln_in_b, w_ada, b_ada, ln_g, ln_b,
              ffn1_w1, ffn1_w3, ffn1_w2, ffn2_w1, ffn2_w3, ffn2_w2,
              w_in, w_out, conv_w, conv_b, lru_wa, lru_ba, lru_wx, lru_bx, lru_lambda,
              sg_ln_g, sg_ln_b, sg_w, sg_b):
    def run(x, c, conv_hists, h0s):
        x = layer_norm(x, ln_in_g, ln_in_b)
        hists, hs, vs = [], [], []
        for l in range(DEPTH):
            x, nh, hl, vn = layer(
                x, c, conv_hists[l], h0s[l], w_ada[l], b_ada[l], ln_g[l], ln_b[l],
                ffn1_w1[l], ffn1_w3[l], ffn1_w2[l], ffn2_w1[l], ffn2_w3[l], ffn2_w2[l],
                w_in[l], w_out[l], conv_w[l], conv_b[l], lru_wa[l], lru_ba[l],
                lru_wx[l], lru_bx[l], lru_lambda[l], sg_ln_g[l], sg_ln_b[l], sg_w[l], sg_b[l])
            hists.append(nh)
            hs.append(hl)
            vs.append(vn)
        return x, jnp.stack(hists), jnp.stack(hs), jnp.stack(vs)

    Bp = x_prompt.shape[0]
    zero_hist = jnp.zeros((DEPTH, Bp, CONV_W - 1, D_LRU), x_prompt.dtype)
    zero_h = jnp.zeros((DEPTH, Bp, D_LRU), x_prompt.dtype)
    y_prompt, conv_p, lru_p, _ = run(x_prompt, c_prompt, zero_hist, zero_h)
    y_sample, conv_s, lru_s, v_s = run(x_sample, c_sample, state_conv, state_lru)
    return (y_prompt, y_sample, conv_p, lru_p, conv_s, lru_s, v_s)
```

```cpp
#include <hip/hip_runtime.h>
#include <hip/hip_cooperative_groups.h>
#include <cstdio>
#include <cstdint>
namespace cg = cooperative_groups;

#define LAS __attribute__((address_space(3)))
__device__ __forceinline__ int lane_id_fresh() { int l; asm volatile("v_mbcnt_lo_u32_b32 %0, -1, 0\n\tv_mbcnt_hi_u32_b32 %0, -1, %0" : "=v"(l)); return l; }
#define TIDX (wv * 64 + lane_id_fresh())
typedef unsigned short bf16_t;
typedef short bf16x8 __attribute__((ext_vector_type(8)));
typedef float f32x4 __attribute__((ext_vector_type(4)));
typedef float f32x2 __attribute__((ext_vector_type(2)));
typedef unsigned u32x4 __attribute__((ext_vector_type(4)));
typedef unsigned u32x2 __attribute__((ext_vector_type(2)));
typedef int v4i __attribute__((ext_vector_type(4)));

constexpr int D = 1024, FF = 2816, MP = 65536, MS = 256, MT = MP + MS, NBID = 16, NMODC = 9 * 1024;
constexpr int DIN = 2048, DLRU = 512, NCHUNK = 520;
constexpr float ALPHA = 1.189207115002721f;
constexpr float LN_EPS = 1e-5f;

constexpr size_t al256(size_t x) { return (x + 255) & ~(size_t)255; }
constexpr size_t WS_BAR = 0;
constexpr size_t WS_CNT = al256(WS_BAR + 3456 * 4);
constexpr size_t WS_MOD = al256(WS_CNT + (size_t)(MT / 256) * 256);
constexpr size_t WS_ZERO_END = al256(WS_MOD + (size_t)NBID * NMODC * 4);
constexpr size_t WS_MODP = WS_ZERO_END;
constexpr size_t WS_W13A = al256(WS_MODP);
constexpr size_t WS_W2A = al256(WS_W13A + (size_t)2 * FF * D * 2);
constexpr size_t WS_W13B = al256(WS_W2A + (size_t)D * FF * 2);
constexpr size_t WS_W2B = al256(WS_W13B + (size_t)2 * FF * D * 2);
constexpr size_t WS_WIN = al256(WS_W2B + (size_t)D * FF * 2);
constexpr size_t WS_WOUT = al256(WS_WIN + (size_t)DIN * D * 2);
constexpr size_t WS_SGW = al256(WS_WOUT + (size_t)D * D * 2);
constexpr size_t WS_LRUB = al256(WS_SGW + (size_t)4 * 128 * 128 * 2);
constexpr size_t WS_AGG = al256(WS_LRUB + (size_t)65536 * 2);
constexpr size_t WS_XBUF = al256(WS_AGG + (size_t)NCHUNK * 2 * 512 * 4);
constexpr size_t WS_SLAB = al256(WS_XBUF + (size_t)MT * 4 * 8);
constexpr size_t WS_X = al256(WS_SLAB + (size_t)11 * 256 * D * 4);
constexpr size_t WS_Y = al256(WS_X + (size_t)MT * D * 2);
constexpr size_t WS_A = al256(WS_Y + (size_t)MT * D * 2);
constexpr size_t WS_A8 = al256(WS_A + (size_t)MT * D * 2);
constexpr size_t WS_H = al256(WS_A8 + (size_t)MT * D);
constexpr size_t WS_P = WS_H;
constexpr size_t WS_AC = al256(WS_P + (size_t)MT * DIN * 2);
constexpr size_t WS_END = al256(WS_H + (size_t)MT * FF * 2);
static_assert(WS_AC + (size_t)MT * 512 * 2 <= WS_END, "AC must fit inside H");

constexpr size_t O_Y = 0;
constexpr size_t O_CONVP = (size_t)MT * D;
constexpr size_t O_LRUP = O_CONVP + 8 * 3 * 512;
constexpr size_t O_CONVS = O_LRUP + 8 * 512;
constexpr size_t O_LRUS = O_CONVS + 8 * 3 * 512;
constexpr size_t O_SGV = O_LRUS + 8 * 512;

constexpr int LDS_BYTES = 161792 + 16;

__device__ __forceinline__ unsigned cvt_pk_bf16(float lo, float hi) { unsigned r; asm("v_cvt_pk_bf16_f32 %0, %1, %2" : "=v"(r) : "v"(lo), "v"(hi)); return r; }
__device__ __forceinline__ unsigned cvt4_fp8(float a, float b, float c, float d) { int p = 0; p = __builtin_amdgcn_cvt_pk_fp8_f32(a, b, p, false); p = __builtin_amdgcn_cvt_pk_fp8_f32(c, d, p, true); return (unsigned)p; }
constexpr float SC_W13 = 256.0f, SC_W2 = 512.0f, SC_H = 8.0f;
__device__ __forceinline__ float lane_read(float v, int src_lane) { return __int_as_float(__builtin_amdgcn_ds_bpermute(src_lane << 2, __float_as_int(v))); }
__device__ __forceinline__ void gather4(float x, bool sw, float& t0, float& t1, float& t2, float& t3) {
    const unsigned xi = __float_as_uint(x);
    const auto r = __builtin_amdgcn_permlane16_swap(xi, xi, false, false);
    const auto a = __builtin_amdgcn_permlane32_swap(r[0], r[0], false, false);
    const auto b = __builtin_amdgcn_permlane32_swap(r[1], r[1], false, false);
    const float e0 = __uint_as_float(a[0]), e2 = __uint_as_float(a[1]), o1 = __uint_as_float(b[0]), o3 = __uint_as_float(b[1]);
    t0 = sw ? o1 : e0; t1 = sw ? e0 : o1; t2 = sw ? o3 : e2; t3 = sw ? e2 : o3;
}
__device__ __forceinline__ bool gather4_calibrate(int fq) {
    float t0, t1, t2, t3; gather4((float)fq, false, t0, t1, t2, t3);
    return __builtin_amdgcn_readfirstlane(__float_as_int(t0)) != 0;
}
__device__ __forceinline__ float bf_lo(unsigned u) { return __uint_as_float(u << 16); }
__device__ __forceinline__ float bf_hi(unsigned u) { return __uint_as_float(u & 0xffff0000u); }
__device__ __forceinline__ float fexp2(float x) { return __builtin_amdgcn_exp2f(x); }
__device__ __forceinline__ float fsigmoid(float x) { return __builtin_amdgcn_rcpf(1.0f + fexp2(-1.4426950408889634f * x)); }
__device__ __forceinline__ float fsilu(float x) { return x * fsigmoid(x); }
__device__ __forceinline__ float gelu_tanh(float x) { const float x2 = x * x; const float t = x * (-2.3022082f + -0.10294324f * x2); return x * __builtin_amdgcn_rcpf(1.0f + fexp2(t)); }
__device__ __forceinline__ int row_bid(int row) { return row < MP ? (row >> 13) : 8 + ((row - MP) >> 5); }
__device__ __forceinline__ float row16_sum(float v) {
    v += __int_as_float(__builtin_amdgcn_update_dpp(0, __float_as_int(v), 0xB1, 0xF, 0xF, true));
    v += __int_as_float(__builtin_amdgcn_update_dpp(0, __float_as_int(v), 0x4E, 0xF, 0xF, true));
    v += __int_as_float(__builtin_amdgcn_update_dpp(0, __float_as_int(v), 0x141, 0xF, 0xF, true));
    v += __int_as_float(__builtin_amdgcn_update_dpp(0, __float_as_int(v), 0x140, 0xF, 0xF, true));
    return v;
}
__device__ __forceinline__ float wave_sum(float v) {
    const int r = __float_as_int(row16_sum(v));
    return (__int_as_float(__builtin_amdgcn_readlane(r, 0)) + __int_as_float(__builtin_amdgcn_readlane(r, 16))) + (__int_as_float(__builtin_amdgcn_readlane(r, 32)) + __int_as_float(__builtin_amdgcn_readlane(r, 48)));
}

namespace pg8 {
constexpr int BM = 256, BK = 64, HALF = 128, HTB = HALF * BK * 2, STAGE_BYTES = 8 * HTB, NXCD = 8, WGM = 8;
__host__ __device__ __forceinline__ int lds_byte(int r, int c) { const int st = (r >> 4) * 2 + (c >> 5), rr = r & 15, cc = c & 31, ob = rr * 64 + cc * 2; return st * 1024 + (ob ^ (((ob >> 9) & 1) << 5)); }
__host__ __device__ __forceinline__ void stage_rc(int b, int& R, int& C) { const int st = b / 1024, sb = b % 1024, swz = sb ^ (((sb >> 9) & 1) << 5); R = (st >> 1) * 16 + swz / 64; C = (st & 1) * 32 + (swz % 64) / 2; }
__host__ __device__ __forceinline__ int perm32(int rho) { const int n = rho >> 4, i = rho & 15; return 8 * (i >> 2) + 4 * n + (i & 3); }
struct Unit { int pm, pn, k0, nt, ks; };
struct Gemm { const bf16_t* A; const bf16_t* Bt; int M, N, K; };
struct StaticOrder {
    int nM, nN, nwg, G, c, ntk;
    __device__ __forceinline__ void init(int M, int N, int K, int G_, int c_) { nM = M / BM; nN = N / BM; nwg = nM * nN; G = G_; c = c_; ntk = K / BK; }
    __device__ __forceinline__ bool next(int i, Unit& u) const {
        const long L = (long)i * G + c; if (L >= nwg) return false;
        int wgid = (int)L; { const int q = nwg / NXCD, r = nwg % NXCD, xcd = wgid % NXCD, off = wgid / NXCD; wgid = (xcd < r ? xcd * (q + 1) : r * (q + 1) + (xcd - r) * q) + off; }
        const int nig = WGM * nN, gid = wgid / nig, fm = gid * WGM, gsz = (nM - fm) < WGM ? (nM - fm) : WGM;
        u.pm = fm + ((wgid % nig) % gsz); u.pn = (wgid % nig) / gsz; u.k0 = 0; u.nt = ntk; u.ks = -1; return true;
    }
};

struct EpiSwiglu {
    static constexpr bool PERM = true;
    unsigned char* H; float sc;
    __device__ __forceinline__ void operator()(const f32x4 (&acc)[2][2][4][2], const Unit& u, int wr, int wc, int fr, int fq, LAS unsigned char*, int, int) const {
        const int row0 = u.pm * BM + wr * 64 + fr, col0 = u.pn * 128 + wc * 32 + 8 * fq;
        float k1 = -1.4426950408889634f * sc, ik2 = 1.0f / (sc * sc * SC_H), lk2 = __builtin_amdgcn_logf(1.0f / (sc * sc * SC_H)); asm volatile("" : "+v"(k1), "+v"(ik2), "+v"(lk2));
#pragma unroll
        for (int ai = 0; ai < 2; ++ai)
#pragma unroll
            for (int m = 0; m < 4; ++m) {
                unsigned char* rowp = H + (size_t)(row0 + ai * HALF + m * 16) * FF + col0;
                float v[8];
#pragma unroll
                for (int n = 0; n < 2; ++n)
#pragma unroll
                    for (int j = 0; j < 4; ++j) {
                        const float a = acc[ai][0][m][n][j], b = acc[ai][1][m][n][j];
                        v[n * 4 + j] = (a * b) * __builtin_amdgcn_rcpf(ik2 + fexp2(__builtin_fmaf(a, k1, lk2)));
                    }
                u32x2 w; w.x = cvt4_fp8(v[0], v[1], v[2], v[3]); w.y = cvt4_fp8(v[4], v[5], v[6], v[7]);
                *(u32x2*)rowp = w;
            }
    }
};
struct EpiResLn {
    static constexpr bool PERM = true;
    bf16_t* Xb; float* outY; bf16_t* A; unsigned char* A8; const float* gate; const float* modn; const float* g; const float* b; float gs;
    unsigned long long* xbuf; unsigned* cnt; unsigned want;
    __device__ __forceinline__ void operator()(f32x4 (&acc)[2][2][4][2], const Unit& u, int wr, int wc, int fr, int fq, LAS unsigned char* lds, int wid, int lane) const {
        asm volatile("" : "+v"(fr), "+v"(fq), "+v"(lane));
        float gsl = gs, one = 1.0f, alpha = ALPHA; asm volatile("" : "+v"(gsl), "+v"(one), "+v"(alpha));
        LAS f32x2* Pt = (LAS f32x2*)(lds + 131072);
        LAS f32x2* St = (LAS f32x2*)(lds + 131072 + 8192);
        const int row0 = u.pm * BM + wr * 64 + fr, col0 = u.pn * BM + wc * 32 + 8 * fq;
        const int bid = (u.pm * BM) >> 13;
        {
            const float* gp = gate + (size_t)bid * NMODC + col0;
            f32x4 gq[2][2];
#pragma unroll
            for (int bj = 0; bj < 2; ++bj) { gq[bj][0] = (*(const f32x4*)(gp + bj * HALF) + one) * gsl; gq[bj][1] = (*(const f32x4*)(gp + bj * HALF + 4) + one) * gsl; }
#pragma unroll
            for (int ai = 0; ai < 2; ++ai)
#pragma unroll
                for (int mp = 0; mp < 2; ++mp) {
                    u32x4 xr[2][2];
#pragma unroll
                    for (int mm = 0; mm < 2; ++mm)
#pragma unroll
                        for (int bj = 0; bj < 2; ++bj) xr[mm][bj] = *(const u32x4*)(Xb + (size_t)(row0 + ai * HALF + (2 * mp + mm) * 16) * D + col0 + bj * HALF);
#pragma unroll
                    for (int mm = 0; mm < 2; ++mm)
#pragma unroll
                        for (int bj = 0; bj < 2; ++bj) {
                            const int m = 2 * mp + mm; const u32x4 r = xr[mm][bj];
                            const f32x4 x0 = (f32x4){bf_lo(r.x), bf_hi(r.x), bf_lo(r.y), bf_hi(r.y)}, x1 = (f32x4){bf_lo(r.z), bf_hi(r.z), bf_lo(r.w), bf_hi(r.w)};
                            acc[ai][bj][m][0] = x0 * alpha + gq[bj][0] * acc[ai][bj][m][0];
                            acc[ai][bj][m][1] = x1 * alpha + gq[bj][1] * acc[ai][bj][m][1];
                        }
                    asm volatile("" : "+v"(acc[ai][0][2 * mp][0]), "+v"(acc[ai][0][2 * mp][1]), "+v"(acc[ai][1][2 * mp][0]), "+v"(acc[ai][1][2 * mp][1]));
                    asm volatile("" : "+v"(acc[ai][0][2 * mp + 1][0]), "+v"(acc[ai][0][2 * mp + 1][1]), "+v"(acc[ai][1][2 * mp + 1][0]), "+v"(acc[ai][1][2 * mp + 1][1]));
                    asm volatile("" ::: "memory");
                }
        }
#pragma unroll
        for (int ai = 0; ai < 2; ++ai)
#pragma unroll
            for (int m = 0; m < 4; ++m) {
                float s = 0.f, q = 0.f;
#pragma unroll
                for (int bj = 0; bj < 2; ++bj)
#pragma unroll
                    for (int n = 0; n < 2; ++n) { const f32x4 x = acc[ai][bj][m][n]; s += (x[0] + x[1]) + (x[2] + x[3]); q += (x[0] * x[0] + x[1] * x[1]) + (x[2] * x[2] + x[3] * x[3]); }
                s += lane_read(s, lane ^ 16); q += lane_read(q, lane ^ 16);
                s += lane_read(s, lane ^ 32); q += lane_read(q, lane ^ 32);
                const float mw = s * (1.0f / 64.0f); q = fmaxf(q - s * mw, 0.f);
                if (fq == 0) Pt[(ai * HALF + wr * 64 + m * 16 + fr) * 4 + wc] = (f32x2){mw, q};
            }
        asm volatile("s_waitcnt lgkmcnt(0)" ::: "memory"); __builtin_amdgcn_s_barrier(); asm volatile("" ::: "memory");
        const int prow = wid * 32 + (lane & 31);
        if (lane < 32) {
            const f32x2 a = Pt[prow * 4 + 0], b2 = Pt[prow * 4 + 1], c = Pt[prow * 4 + 2], d = Pt[prow * 4 + 3];
            const float mt = (a.x + b2.x + c.x + d.x) * 0.25f;
            const float da = a.x - mt, db = b2.x - mt, dc = c.x - mt, dd = d.x - mt;
            const float m2 = (a.y + b2.y) + (c.y + d.y) + 64.0f * ((da * da + db * db) + (dc * dc + dd * dd));
            unsigned long long* slot = xbuf + ((size_t)(u.pm * BM + prow) * 4 + u.pn);
            __hip_atomic_store(slot, ((unsigned long long)__float_as_uint(m2) << 32) | __float_as_uint(mt), __ATOMIC_RELAXED, __HIP_MEMORY_SCOPE_AGENT);
        }
        asm volatile("s_waitcnt vmcnt(0)" ::: "memory");
        if (lane == 0) __hip_atomic_fetch_add(cnt + 64 * u.pm, 1u, __ATOMIC_RELAXED, __HIP_MEMORY_SCOPE_AGENT);
        if (wid == 0) {
            unsigned sp = 0;
            while ((unsigned)__builtin_amdgcn_readfirstlane(__hip_atomic_load(cnt + 64 * u.pm, __ATOMIC_RELAXED, __HIP_MEMORY_SCOPE_AGENT)) < want) { __builtin_amdgcn_s_sleep(2); if (++sp > (1u << 22)) break; }
            __builtin_amdgcn_fence(__ATOMIC_ACQUIRE, "agent");
        }
        asm volatile("s_waitcnt vmcnt(0) lgkmcnt(0)" ::: "memory"); __builtin_amdgcn_s_barrier(); asm volatile("" ::: "memory");
        if (lane < 32) {
            const unsigned long long* slot = xbuf + (size_t)(u.pm * BM + prow) * 4; float mt[4], m2[4]; float ms = 0.f;
#pragma unroll
            for (int t = 0; t < 4; ++t) { const unsigned long long w = __hip_atomic_load(slot + t, __ATOMIC_RELAXED, __HIP_MEMORY_SCOPE_AGENT); mt[t] = __uint_as_float((unsigned)w); m2[t] = __uint_as_float((unsigned)(w >> 32)); ms += mt[t]; }
            const float mean = ms * 0.25f; float q = 0.f;
#pragma unroll
            for (int t = 0; t < 4; ++t) { const float dm = mt[t] - mean; q += m2[t] + 256.0f * dm * dm; }
            St[prow] = (f32x2){mean, rsqrtf(q * (1.0f / 1024.0f) + LN_EPS)};
        }
        asm volatile("s_waitcnt lgkmcnt(0)" ::: "memory"); __builtin_amdgcn_s_barrier(); asm volatile("" ::: "memory");
#pragma unroll
        for (int bj = 0; bj < 2; ++bj) {
            const f32x4 gv0 = *(const f32x4*)(g + col0 + bj * HALF), gv1 = *(const f32x4*)(g + col0 + bj * HALF + 4);
            const f32x4 bv0 = *(const f32x4*)(b + col0 + bj * HALF), bv1 = *(const f32x4*)(b + col0 + bj * HALF + 4);
            const float* mb = modn + (size_t)bid * NMODC + col0 + bj * HALF;
            f32x4 sh0, sh1, sc0, sc1;
            if (!outY) { sh0 = *(const f32x4*)(mb); sh1 = *(const f32x4*)(mb + 4); sc0 = *(const f32x4*)(mb + D) + 1.0f; sc1 = *(const f32x4*)(mb + D + 4) + 1.0f; }
#pragma unroll
            for (int ai = 0; ai < 2; ++ai)
#pragma unroll
                for (int m = 0; m < 4; ++m) {
                    const int r = ai * HALF + wr * 64 + m * 16 + fr, row = u.pm * BM + r; const f32x2 sr = St[r];
                    const float nm = -sr.x * sr.y;
                    const f32x4 y0 = (acc[ai][bj][m][0] * sr.y + nm) * gv0 + bv0, y1 = (acc[ai][bj][m][1] * sr.y + nm) * gv1 + bv1;
                    const size_t off = (size_t)row * D + col0 + bj * HALF;
                    if (outY) { *(f32x4*)(outY + off) = y0; *(f32x4*)(outY + off + 4) = y1; }
                    else {
                        u32x4 w; w.x = cvt_pk_bf16(y0[0], y0[1]); w.y = cvt_pk_bf16(y0[2], y0[3]); w.z = cvt_pk_bf16(y1[0], y1[1]); w.w = cvt_pk_bf16(y1[2], y1[3]);
                        *(u32x4*)(Xb + off) = w;
                        {
                            const f32x4 a0 = y0 * sc0 + sh0, a1 = y1 * sc1 + sh1;
                            if (A8) { u32x2 w8; w8.x = cvt4_fp8(a0[0], a0[1], a0[2], a0[3]); w8.y = cvt4_fp8(a1[0], a1[1], a1[2], a1[3]); *(u32x2*)(A8 + off) = w8; }
                            else { u32x4 wa; wa.x = cvt_pk_bf16(a0[0], a0[1]); wa.y = cvt_pk_bf16(a0[2], a0[3]); wa.z = cvt_pk_bf16(a1[0], a1[1]); wa.w = cvt_pk_bf16(a1[2], a1[3]); *(u32x4*)(A + off) = wa; }
                        }
                    }
                    if (m & 1) asm volatile("" ::: "memory");
                }
        }
    }
};
struct PanelOrder {
    int nwg, G, vc, ntk;
    __device__ __forceinline__ void init(int K, int G_, int c_) { ntk = K / BK; nwg = (MP / BM) * 4; G = G_; vc = (c_ & 7) * (G_ >> 3) + (c_ >> 3); }
    __device__ __forceinline__ bool next(int i, Unit& u) const { const int L = i * G + vc; if (L >= nwg) return false; u.pm = L >> 2; u.pn = L & 3; u.k0 = 0; u.nt = ntk; u.ks = -1; return true; }
};
struct SubOrder {
    int n, vc, nts;
    __device__ __forceinline__ void init(int ntk, int slice, int G_, int c_) { n = 4 * (ntk / slice); vc = (c_ & 7) * (G_ >> 3) + (c_ >> 3); asm volatile("" : "+s"(slice)); nts = slice; }
    __device__ __forceinline__ bool next(int i, Unit& u) const { if (i > 0 || vc >= n) return false; u.pm = MP / BM; u.pn = vc & 3; u.ks = vc >> 2; u.k0 = nts * (vc >> 2); u.nt = nts; return true; }
};
struct EpiSlab {
    static constexpr bool PERM = true;
    float* slab;
    __device__ __forceinline__ void operator()(const f32x4 (&acc)[2][2][4][2], const Unit& u, int wr, int wc, int fr, int fq, LAS unsigned char*, int, int) const {
        float* sp = slab + ((size_t)u.ks * 256 + wr * 64 + fr) * D + u.pn * BM + wc * 32 + 8 * fq;
#pragma unroll
        for (int ai = 0; ai < 2; ++ai)
#pragma unroll
            for (int m = 0; m < 4; ++m)
#pragma unroll
                for (int bj = 0; bj < 2; ++bj) { float* q = sp + (size_t)(ai * HALF + m * 16) * D + bj * HALF; *(f32x4*)q = acc[ai][bj][m][0]; *(f32x4*)(q + 4) = acc[ai][bj][m][1]; }
    }
};
struct EpiP {
    static constexpr bool PERM = true;
    bf16_t* O; int ldc;
    __device__ __forceinline__ void operator()(const f32x4 (&acc)[2][2][4][2], const Unit& u, int wr, int wc, int fr, int fq, LAS unsigned char*, int, int) const {
        const int row0 = u.pm * BM + wr * 64 + fr, col0 = u.pn * BM + wc * 32 + 8 * fq;
#pragma unroll
        for (int ai = 0; ai < 2; ++ai)
#pragma unroll
            for (int m = 0; m < 4; ++m) {
                bf16_t* rowp = O + (size_t)(row0 + ai * HALF + m * 16) * ldc + col0;
#pragma unroll
                for (int bj = 0; bj < 2; ++bj) {
                    const f32x4 v0 = acc[ai][bj][m][0], v1 = acc[ai][bj][m][1];
                    u32x4 w; w.x = cvt_pk_bf16(v0[0], v0[1]); w.y = cvt_pk_bf16(v0[2], v0[3]); w.z = cvt_pk_bf16(v1[0], v1[1]); w.w = cvt_pk_bf16(v1[2], v1[3]);
                    *(u32x4*)(rowp + bj * HALF) = w;
                }
            }
    }
};

template <bool FP8, class Epi, class Sched>
__device__ __forceinline__ void gemm_phase(LAS unsigned char* lds, const Gemm g, const Sched& S, const Epi& E, const int wv) {
    int tid_ = TIDX; asm volatile("" : "+v"(tid_)); const int tid = tid_, wid = __builtin_amdgcn_readfirstlane(tid >> 6), lane = tid & 63, wr = wid >> 2, wc = wid & 3, fr = lane & 15, fq = lane >> 4;
    const int K = g.K;
    unsigned voffA[2], voffB[2];
#pragma unroll
    for (int i = 0; i < 2; ++i) { int R, C; stage_rc(tid * 16 + i * 8192, R, C); const int Rb = Epi::PERM ? ((R & ~31) + perm32(R & 31)) : R;
        voffA[i] = (unsigned)(R * K + C) * 2u; voffB[i] = (unsigned)(Rb * K + C) * 2u; }
    const unsigned kstep = (unsigned)(BK * 2);
    const unsigned hstep = (unsigned)HALF * (unsigned)K * 2u;
    const unsigned tstep = 2u * hstep;
    const __amdgpu_buffer_rsrc_t rA = __builtin_amdgcn_make_buffer_rsrc((void*)g.A, (short)0, 0x7ffffff0, 0x00020000);
    const __amdgpu_buffer_rsrc_t rB = __builtin_amdgcn_make_buffer_rsrc((void*)g.Bt, (short)0, 0x7ffffff0, 0x00020000);
    const unsigned ldsw = (unsigned)wid * 1024u;
    const int aoff = lds_byte(wr * 64 + fr, fq * 8), boff = lds_byte(wc * 32 + fr, fq * 8);
#define PG8_SA(b, h) (((b) * 2 + (h)) * HTB)
#define PG8_SB(b, h) ((4 + (b) * 2 + (h)) * HTB)
#define PG8_STAGE(bufoff, rsrc, soff, voff) do { _Pragma("unroll") for (int _i = 0; _i < 2; ++_i) \
        __builtin_amdgcn_raw_ptr_buffer_load_lds(rsrc, (LAS void*)(lds + (bufoff) + ldsw + _i * 8192), 16, (voff)[_i], (soff), 0, 0); } while (0)
#define PG8_LDA(dst, b, h) do { _Pragma("unroll") for (int m = 0; m < 4; ++m) _Pragma("unroll") for (int k = 0; k < 2; ++k) dst[m][k] = *(const LAS bf16x8*)(lds + PG8_SA(b, h) + aoff + m * 2048 + k * 1024); } while (0)
#define PG8_LDB(dst, b, h) do { _Pragma("unroll") for (int n = 0; n < 2; ++n) _Pragma("unroll") for (int k = 0; k < 2; ++k) dst[n][k] = *(const LAS bf16x8*)(lds + PG8_SB(b, h) + boff + n * 2048 + k * 1024); } while (0)
#define PG8_MMA(ai, bj, At, Bt) do { __builtin_amdgcn_s_setprio(1); _Pragma("unroll") for (int m = 0; m < 4; ++m) _Pragma("unroll") for (int n = 0; n < 2; ++n) { \
        if constexpr (FP8) { acc[ai][bj][m][n] = __builtin_amdgcn_mfma_scale_f32_16x16x128_f8f6f4(__builtin_shufflevector((v4i)Bt[n][0], (v4i)Bt[n][1], 0, 1, 2, 3, 4, 5, 6, 7), \
                                 __builtin_shufflevector((v4i)At[m][0], (v4i)At[m][1], 0, 1, 2, 3, 4, 5, 6, 7), acc[ai][bj][m][n], 0, 0, 0, 0, 0, 0); } \
        else { _Pragma("unroll") for (int k = 0; k < 2; ++k) acc[ai][bj][m][n] = __builtin_amdgcn_mfma_f32_16x16x32_bf16(Bt[n][k], At[m][k], acc[ai][bj][m][n], 0, 0, 0); } } \
        __builtin_amdgcn_s_setprio(0); } while (0)
#define PG8_WAIT_V(n) asm volatile("s_waitcnt vmcnt(" #n ")" ::: "memory")
#define PG8_WAIT_L(n) asm volatile("s_waitcnt lgkmcnt(" #n ")" ::: "memory")
#define PG8_BAR __builtin_amdgcn_s_barrier()
#define PG8_SCHED __builtin_amdgcn_sched_barrier(0)
    Unit cur, nxt; int ui = 0;
    if (!S.next(0, cur)) return;
    f32x4 acc[2][2][4][2];
#pragma unroll
    for (int a = 0; a < 2; ++a)
#pragma unroll
        for (int b = 0; b < 2; ++b)
#pragma unroll
            for (int m = 0; m < 4; ++m)
#pragma unroll
                for (int n = 0; n < 2; ++n) acc[a][b][m][n] = (f32x4){0.f, 0.f, 0.f, 0.f};
    bf16x8 At[4][2], B0[2][2], B1[2][2];
    unsigned cA = (unsigned)cur.pm * tstep + (unsigned)cur.k0 * kstep, cB = (unsigned)cur.pn * tstep + (unsigned)cur.k0 * kstep;
    PG8_STAGE(PG8_SB(0, 0), rB, cB, voffB); PG8_STAGE(PG8_SB(0, 1), rB, cB + hstep, voffB); PG8_STAGE(PG8_SA(0, 0), rA, cA, voffA); PG8_STAGE(PG8_SA(0, 1), rA, cA + hstep, voffA);
    if (wr == 1) PG8_BAR;
    PG8_WAIT_V(2); PG8_BAR;
    PG8_STAGE(PG8_SB(1, 0), rB, cB + kstep, voffB); PG8_STAGE(PG8_SA(1, 0), rA, cA + kstep, voffA); PG8_STAGE(PG8_SB(1, 1), rB, cB + hstep + kstep, voffB);
    PG8_WAIT_V(6); PG8_BAR;
    for (;;) {
        const bool has_next = S.next(ui + 1, nxt);
        const unsigned nA = has_next ? (unsigned)nxt.pm * tstep + (unsigned)nxt.k0 * kstep : cA, nB = has_next ? (unsigned)nxt.pn * tstep + (unsigned)nxt.k0 * kstep : cB;
        const int nt = cur.nt;
        for (int t = 0; t < nt; t += 2) {
            const bool last = (t == nt - 2);
            const unsigned a1 = cA + (unsigned)(t + 1) * kstep;
            const unsigned a2 = last ? nA : cA + (unsigned)(t + 2) * kstep, b2 = last ? nB : cB + (unsigned)(t + 2) * kstep;
            const unsigned a3 = a2 + kstep, b3 = b2 + kstep;
            PG8_LDB(B0, 0, 0); PG8_LDB(B1, 0, 1); PG8_SCHED; PG8_LDA(At, 0, 0); PG8_STAGE(PG8_SA(1, 1), rA, a1 + hstep, voffA);
            PG8_WAIT_V(8); PG8_WAIT_L(0); PG8_BAR; PG8_MMA(0, 0, At, B0); PG8_MMA(0, 1, At, B1); PG8_BAR; PG8_SCHED;
            PG8_LDA(At, 0, 1); PG8_STAGE(PG8_SB(0, 0), rB, b2, voffB); PG8_STAGE(PG8_SB(0, 1), rB, b2 + hstep, voffB); PG8_STAGE(PG8_SA(0, 0), rA, a2, voffA);
            PG8_WAIT_V(8); PG8_WAIT_L(0); PG8_BAR; PG8_MMA(1, 0, At, B0); PG8_MMA(1, 1, At, B1); PG8_BAR; PG8_SCHED;
            PG8_LDB(B0, 1, 0); PG8_LDB(B1, 1, 1); PG8_SCHED; PG8_LDA(At, 1, 0); PG8_STAGE(PG8_SA(0, 1), rA, a2 + hstep, voffA);
            PG8_WAIT_V(8); PG8_WAIT_L(0); PG8_BAR; PG8_MMA(0, 0, At, B0); PG8_MMA(0, 1, At, B1); PG8_BAR; PG8_SCHED;
            PG8_LDA(At, 1, 1); PG8_STAGE(PG8_SB(1, 0), rB, b3, voffB); PG8_STAGE(PG8_SB(1, 1), rB, b3 + hstep, voffB); PG8_STAGE(PG8_SA(1, 0), rA, a3, voffA);
            PG8_WAIT_V(8); PG8_WAIT_L(0); PG8_BAR; PG8_MMA(1, 0, At, B0); PG8_MMA(1, 1, At, B1); PG8_BAR; PG8_SCHED;
        }
        if (wr == 0) PG8_BAR;
        { const int l2 = lane_id_fresh(); E(acc, cur, wr, wc, l2 & 15, l2 >> 4, lds, wid, l2); }
        if (!has_next) break;
#pragma unroll
        for (int a = 0; a < 2; ++a)
#pragma unroll
            for (int b = 0; b < 2; ++b)
#pragma unroll
                for (int m = 0; m < 4; ++m)
#pragma unroll
                    for (int n = 0; n < 2; ++n) acc[a][b][m][n] = (f32x4){0.f, 0.f, 0.f, 0.f};
        cur = nxt; cA = nA; cB = nB; ++ui;
        if (wr == 1) PG8_BAR;
    }
    PG8_WAIT_V(0);
    PG8_BAR;
#undef PG8_SA
#undef PG8_SB
#undef PG8_STAGE
#undef PG8_LDA
#undef PG8_LDB
#undef PG8_MMA
#undef PG8_WAIT_V
#undef PG8_WAIT_L
#undef PG8_BAR
#undef PG8_SCHED
}
}

#define XB_TMO      128
#define XB_XCNT(j)  (256  + 64 * (j))
#define XB_XSUB(j)  (1280 + 64 * (j))
#define XB_XGEN(j)  (2304 + 64 * (j))
#define XB_TOP      3328
#define XB_TOPGEN   3392
#define XCD_BAR_WORDS 3456
#define XB_SPIN_CAP (1u << 22)
__device__ __forceinline__ unsigned xb_ld(unsigned* p)              { return __hip_atomic_load(p, __ATOMIC_RELAXED, __HIP_MEMORY_SCOPE_AGENT); }
__device__ __forceinline__ unsigned xb_add(unsigned* p, unsigned v) { return __hip_atomic_fetch_add(p, v, __ATOMIC_RELAXED, __HIP_MEMORY_SCOPE_AGENT); }
__device__ __forceinline__ unsigned xb_xcc_id() { return (unsigned)__builtin_amdgcn_s_getreg((3 << 11) | 20) & 0xFu; }
#define XB_SPIN(cond, bar) do { unsigned _sp = 0; while (cond) { __builtin_amdgcn_s_sleep(1); \
    if ((++_sp & 255u) == 0u) { if (xb_ld(&(bar)[XB_TMO])) break; if (_sp > XB_SPIN_CAP) { atomicAdd(&(bar)[XB_TMO], 1u); break; } } } } while (0)
struct XcdBarrier { unsigned* bar; unsigned x; volatile LAS unsigned* st; };
__device__ __forceinline__ XcdBarrier xcd_barrier_post(unsigned* bar, volatile LAS unsigned* st, const int wv) {
    XcdBarrier b; b.bar = bar; b.x = xb_xcc_id(); b.st = st;
    if (TIDX == 0) (void)xb_add(&bar[XB_XCNT(b.x)], 1u);
    return b;
}
__device__ __forceinline__ void xcd_barrier_complete(unsigned* bar, unsigned x, unsigned& nloc, unsigned& nx) {
    const unsigned G = gridDim.x * gridDim.y * gridDim.z;
    unsigned sum, cnt, mine, sp = 0u;
    for (;;) {
        sum = 0u; cnt = 0u; mine = 0u;
#pragma unroll
        for (unsigned j = 0; j < 16; ++j) { const unsigned c = xb_ld(&bar[XB_XCNT(j)]); sum += c; cnt += (c > 0u) ? 1u : 0u; mine = (j == x) ? c : mine; }
        if (sum == G) break;
        __builtin_amdgcn_s_sleep(1);
        if ((++sp & 255u) == 0u) { if (xb_ld(&bar[XB_TMO])) break; if (sp > XB_SPIN_CAP) { atomicAdd(&bar[XB_TMO], 1u); break; } }
    }
    nloc = mine > 0u ? mine : 1u; nx = cnt > 0u ? cnt : 1u;
}
__device__ __forceinline__ void xcd_barrier(unsigned* const barp, volatile LAS unsigned* const stp, const int wv) {
    XcdBarrier b; b.bar = barp; b.st = stp; b.x = xb_xcc_id();
    asm volatile("s_waitcnt vmcnt(0)" ::: "memory");
    __syncthreads();
    if (TIDX == 0) {
        unsigned* bar = b.bar;
        __builtin_amdgcn_s_waitcnt(0);
        unsigned nloc = b.st[0], nx = b.st[1];
        if (nloc == 0u) { xcd_barrier_complete(bar, b.x, nloc, nx); b.st[0] = nloc; b.st[1] = nx; }
        const unsigned old = xb_add(&bar[XB_XSUB(b.x)], 1u);
        const unsigned gen = old / nloc;
        if (old + 1u == (gen + 1u) * nloc) {
            __builtin_amdgcn_fence(__ATOMIC_RELEASE, "agent");
            asm volatile("s_waitcnt vmcnt(0)" ::: "memory");
            const unsigned og = xb_add(&bar[XB_TOP], 1u);
            const unsigned tg = og / nx;
            if (og + 1u == (tg + 1u) * nx) xb_add(&bar[XB_TOPGEN], 1u);
            else XB_SPIN(xb_ld(&bar[XB_TOPGEN]) == tg, bar);
            __builtin_amdgcn_fence(__ATOMIC_ACQUIRE, "agent");
            xb_add(&bar[XB_XGEN(b.x)], 1u);
            asm volatile("s_waitcnt vmcnt(0)" ::: "memory");
        } else {
            XB_SPIN(xb_ld(&bar[XB_XGEN(b.x)]) == gen, bar);
            __builtin_amdgcn_fence(__ATOMIC_ACQUIRE, "agent");
            asm volatile("s_waitcnt vmcnt(0)" ::: "memory");
        }
    }
    __syncthreads();
}

struct Params {
    const float* in[31];
    float* out;
    unsigned char* ws;
    int nprog;
    int prog[27];
};
enum { I_XP = 0, I_XS, I_CP, I_CS, I_SCONV, I_SLRU, I_LNIG, I_LNIB, I_WADA, I_BADA, I_LNG, I_LNB, I_F1W1, I_F1W3, I_F1W2, I_F2W1, I_F2W3, I_F2W2,
       I_WIN, I_WOUT, I_CONVW, I_CONVB, I_LWA, I_LBA, I_LWX, I_LBX, I_LLAM, I_SGLG, I_SGLB, I_SGW, I_SGB };
enum { PH_PREP = 0, PH_MOD, PH_LN0, PH_G1, PH_G2, PH_LN1, PH_G3, PH_M1, PH_M2, PH_G4, PH_LN2, PH_G5, PH_G6, PH_LN3, PH_COUNT, PH_M1S, PH_M1L, PH_F2, PH_F4, PH_F6 };

__device__ __forceinline__ void transpose_item(const float* W, int K, int N, bf16_t* WT, int k0, int n0, int drow0, LAS float* scr, int lane) {
#pragma unroll
    for (int hh = 0; hh < 2; ++hh) {
        float tv[16];
#pragma unroll
        for (int i = 0; i < 16; ++i) tv[i] = W[(size_t)(k0 + 2 * (16 * hh + i) + (lane >> 5)) * N + n0 + (lane & 31)];
#pragma unroll
        for (int i = 0; i < 16; ++i) scr[(2 * (16 * hh + i) + (lane >> 5)) * 33 + (lane & 31)] = tv[i];
    }
    asm volatile("s_waitcnt lgkmcnt(0)" ::: "memory");
    const int c = lane & 7;
#pragma unroll
    for (int j = 0; j < 4; ++j) { const int n = (lane >> 3) + 8 * j; const LAS float* s = scr + (8 * c) * 33 + n;
        u32x4 o; o.x = cvt_pk_bf16(s[0 * 33], s[1 * 33]); o.y = cvt_pk_bf16(s[2 * 33], s[3 * 33]); o.z = cvt_pk_bf16(s[4 * 33], s[5 * 33]); o.w = cvt_pk_bf16(s[6 * 33], s[7 * 33]);
        *(u32x4*)(WT + (size_t)(drow0 + n) * K + k0 + 8 * c) = o; }
    asm volatile("s_waitcnt lgkmcnt(0)" ::: "memory");
}

__device__ __forceinline__ void transpose_item_f8(const float* W, int K, int N, unsigned char* WT, int k0, int n0, int drow0, float scale, LAS float* scr, int lane) {
#pragma unroll
    for (int hh = 0; hh < 2; ++hh) {
        float tv[16];
#pragma unroll
        for (int i = 0; i < 16; ++i) tv[i] = W[(size_t)(k0 + 2 * (16 * hh + i) + (lane >> 5)) * N + n0 + (lane & 31)];
#pragma unroll
        for (int i = 0; i < 16; ++i) scr[(2 * (16 * hh + i) + (lane >> 5)) * 33 + (lane & 31)] = tv[i] * scale;
    }
    asm volatile("s_waitcnt lgkmcnt(0)" ::: "memory");
#pragma unroll
    for (int t = 0; t < 2; ++t) { const int i = lane + 64 * t, n = i >> 2, c = i & 3; const LAS float* s = scr + (16 * c) * 33 + n;
        u32x4 o;
        o.x = cvt4_fp8(s[0 * 33], s[1 * 33], s[2 * 33], s[3 * 33]); o.y = cvt4_fp8(s[4 * 33], s[5 * 33], s[6 * 33], s[7 * 33]);
        o.z = cvt4_fp8(s[8 * 33], s[9 * 33], s[10 * 33], s[11 * 33]); o.w = cvt4_fp8(s[12 * 33], s[13 * 33], s[14 * 33], s[15 * 33]);
        *(u32x4*)(WT + (size_t)(drow0 + n) * K + k0 + 16 * c) = o; }
    asm volatile("s_waitcnt lgkmcnt(0)" ::: "memory");
}

__device__ __forceinline__ void phase_prep(const Params& p, LAS unsigned char* lds, const int wv) {
    int tid_ = TIDX; asm volatile("" : "+v"(tid_)); const int tid = tid_, lane = tid & 63, w = __builtin_amdgcn_readfirstlane(tid >> 6);
    const int gw = blockIdx.x * 8 + w, NGW = gridDim.x * 8;
    LAS float* scr = (LAS float*)(lds + w * 8448);
    unsigned char* W13A = p.ws + WS_W13A; unsigned char* W2A = p.ws + WS_W2A; unsigned char* W13B = p.ws + WS_W13B; unsigned char* W2B = p.ws + WS_W2B;
    bf16_t* WIN = (bf16_t*)(p.ws + WS_WIN); bf16_t* WOUT = (bf16_t*)(p.ws + WS_WOUT);
    constexpr int I13 = (D / 64) * (FF / 32);
    constexpr int I2 = (FF / 64) * (D / 32);
    constexpr int IIN = (D / 64) * (DIN / 32);
    constexpr int IOUT = (D / 64) * (D / 32);
    constexpr int NTR = 4 * I13 + 2 * I2 + IIN + IOUT;
    constexpr int NMODT = 144 * 16;
    for (int it = gw; it < NTR + NMODT; it += NGW) {
        int r = it;
        if (r < 4 * I13) {
            const int mat = r / I13; r -= mat * I13;
            const int nblk = FF / 32, kb = r / nblk, nb = r % nblk, n0 = 32 * nb;
            const float* W = p.in[mat == 0 ? I_F1W1 : mat == 1 ? I_F1W3 : mat == 2 ? I_F2W1 : I_F2W3];
            unsigned char* WT = (mat < 2) ? W13A : W13B;
            const int drow0 = 256 * (n0 >> 7) + (n0 & 127) + ((mat & 1) ? 128 : 0);
            transpose_item_f8(W, D, FF, WT, 64 * kb, n0, drow0, SC_W13, scr, lane);
            continue;
        }
        r -= 4 * I13;
        if (r < 2 * I2) {
            const int mat = r / I2; r -= mat * I2;
            const int nblk = D / 32, kb = r / nblk, nb = r % nblk;
            transpose_item_f8(p.in[mat ? I_F2W2 : I_F1W2], FF, D, mat ? W2B : W2A, 64 * kb, 32 * nb, 32 * nb, SC_W2, scr, lane);
            continue;
        }
        r -= 2 * I2;
        if (r < IIN) { const int nblk = DIN / 32, kb = r / nblk, nb = r % nblk; transpose_item(p.in[I_WIN], D, DIN, WIN, 64 * kb, 32 * nb, 32 * nb, scr, lane); continue; }
        r -= IIN;
        if (r < IOUT) { const int nblk = D / 32, kb = r / nblk, nb = r % nblk; transpose_item(p.in[I_WOUT], D, D, WOUT, 64 * kb, 32 * nb, 32 * nb, scr, lane); continue; }
        r -= IOUT;
        {
            const int cgp = r >> 4, ks = r & 15, n = 64 * cgp + lane, k0 = 64 * ks;
            float sil[16], acc[16];
#pragma unroll
            for (int b = 0; b < 16; ++b) { const float cv = (b < 8) ? p.in[I_CP][b * D + k0 + lane] : p.in[I_CS][(b - 8) * D + k0 + lane]; sil[b] = fsilu(cv); acc[b] = 0.f; }
            const float* wa = p.in[I_WADA] + (size_t)k0 * NMODC + n;
#pragma unroll 8
            for (int kk = 0; kk < 64; ++kk) {
                const float wv_ = wa[(size_t)kk * NMODC];
#pragma unroll
                for (int b = 0; b < 16; ++b) acc[b] += __int_as_float(__builtin_amdgcn_readlane(__float_as_int(sil[b]), kk)) * wv_;
            }
            float* mp = (float*)(p.ws + WS_MOD);
            const float bias = (ks == 0) ? p.in[I_BADA][n] : 0.f;
#pragma unroll
            for (int b = 0; b < 16; ++b) atomicAdd(mp + (size_t)b * NMODC + n, acc[b] + bias);
        }
    }
    const int gt = blockIdx.x * 512 + tid, NGT = gridDim.x * 512;
    bf16_t* sgw = (bf16_t*)(p.ws + WS_SGW);
    for (int i = gt; i < 65536; i += NGT) { const int ii = (i >> 7) & 127, jj = i & 127; const float v = (jj <= ii) ? p.in[I_SGW][i] : 0.f; sgw[i] = (bf16_t)(cvt_pk_bf16(v, 0.f) & 0xffffu); }
    bf16_t* lrub = (bf16_t*)(p.ws + WS_LRUB);
    for (int i = gt; i < 65536; i += NGT) {
        const int j = i & 7, ln = (i >> 3) & 63, ks = (i >> 9) & 1, nb = (i >> 10) & 3, mat = (i >> 12) & 1, h = i >> 13;
        const int fr = ln & 15, fq = ln >> 4, k = 32 * ks + 8 * fq + j, n = 4 * fr + nb;
        const float v = p.in[mat ? I_LWX : I_LWA][(h * 64 + k) * 64 + n];
        lrub[i] = (bf16_t)(cvt_pk_bf16(v, 0.f) & 0xffffu);
    }
}

__device__ __forceinline__ void phase_mod(const Params& p, const int wv) {
    int tid_ = TIDX; asm volatile("" : "+v"(tid_)); const int gt = blockIdx.x * 512 + tid_, NGT = gridDim.x * 512;
    const float* mp = (const float*)(p.ws + WS_MODP); float* mod = (float*)(p.ws + WS_MOD);
    for (int i = gt; i < NBID * NMODC; i += NGT) {
        const int b = i / NMODC, n = i - b * NMODC; float s = p.in[I_BADA][n];
#pragma unroll
        for (int ks = 0; ks < 16; ++ks) s += mp[(size_t)(ks * 16 + b) * NMODC + n];
        mod[i] = s;
    }
}

__device__ __forceinline__ void ln_pass(const float* srcP, const float* srcS, bf16_t* dstX, unsigned char* dstA8, const float* g, const float* b, const float* mod, int kmod, const int wv) {
    int tid_ = TIDX; asm volatile("" : "+v"(tid_)); const int tid = tid_, lane = tid & 63, w = __builtin_amdgcn_readfirstlane(tid >> 6);
    const int gw = blockIdx.x * 8 + w, NGW = gridDim.x * 8;
    f32x4 gv[4], bv[4];
#pragma unroll
    for (int j = 0; j < 4; ++j) { gv[j] = *(const f32x4*)(g + 4 * lane + 256 * j); bv[j] = *(const f32x4*)(b + 4 * lane + 256 * j); }
    f32x4 nv[2][4], shv[2][4], scv[2][4]; int cbid[2] = {-1, -1};
#define LN_LOAD(dst, rowa_) do { _Pragma("unroll") for (int t = 0; t < 2; ++t) { const int row = (rowa_) + t * NGW; if (row < MT) { \
        const float* xr = (row >= MP) ? srcS + (size_t)(row - MP) * D : srcP + (size_t)row * D; \
        _Pragma("unroll") for (int j = 0; j < 4; ++j) dst[t][j] = *(const f32x4*)(xr + 4 * lane + 256 * j); } } } while (0)
    LN_LOAD(nv, gw);
    for (int rowa = gw; rowa < MT; rowa += 2 * NGW) {
        f32x4 v[2][4]; float s[2], s2[2];
#pragma unroll
        for (int t = 0; t < 2; ++t)
#pragma unroll
            for (int j = 0; j < 4; ++j) v[t][j] = nv[t][j];
        if (rowa + 2 * NGW < MT) LN_LOAD(nv, rowa + 2 * NGW);
#pragma unroll
        for (int t = 0; t < 2; ++t) {
            float a = 0.f, q = 0.f;
#pragma unroll
            for (int j = 0; j < 4; ++j) { a += (v[t][j][0] + v[t][j][1]) + (v[t][j][2] + v[t][j][3]); q += (v[t][j][0] * v[t][j][0] + v[t][j][1] * v[t][j][1]) + (v[t][j][2] * v[t][j][2] + v[t][j][3] * v[t][j][3]); }
            s[t] = a; s2[t] = q;
        }
#pragma unroll
        for (int t = 0; t < 2; ++t) {
            const int row = rowa + t * NGW;
            if (row < MT) {
                const float mean = wave_sum(s[t]) * (1.0f / D);
                const float var = fmaxf(wave_sum(s2[t]) * (1.0f / D) - mean * mean, 0.f);
                const float rstd = rsqrtf(var + LN_EPS);
                const int bid = row_bid(row);
                if (bid != cbid[t]) {
                    cbid[t] = bid; const float* mb = mod + (size_t)bid * NMODC + (size_t)(3 * kmod) * D;
#pragma unroll
                    for (int j = 0; j < 4; ++j) { shv[t][j] = *(const f32x4*)(mb + 4 * lane + 256 * j); scv[t][j] = *(const f32x4*)(mb + D + 4 * lane + 256 * j) + 1.0f; }
                }
#pragma unroll
                for (int j = 0; j < 4; ++j) {
                    const f32x4 y = (v[t][j] - mean) * rstd * gv[j] + bv[j];
                    u32x2 ox; ox.x = cvt_pk_bf16(y[0], y[1]); ox.y = cvt_pk_bf16(y[2], y[3]);
                    *(u32x2*)(dstX + (size_t)row * D + 4 * lane + 256 * j) = ox;
                    const f32x4 a = y * scv[t][j] + shv[t][j];
                    *(unsigned*)(dstA8 + (size_t)row * D + 4 * lane + 256 * j) = cvt4_fp8(a[0], a[1], a[2], a[3]);
                }
            }
        }
    }
#undef LN_LOAD
}

__device__ __forceinline__ void phase_fin(const Params& p, int k, int nsplit, float accs, const int wv) {
    int tid_ = TIDX; asm volatile("" : "+v"(tid_)); const int tid = tid_, lane = tid & 63, w = __builtin_amdgcn_readfirstlane(tid >> 6);
    const int r = blockIdx.x * 8 + w; if (r >= MS) return;
    const int row = MP + r; const int bid = row_bid(row);
    const float* mod = (const float*)(p.ws + WS_MOD); const float* slab = (const float*)(p.ws + WS_SLAB);
    bf16_t* Xb = (bf16_t*)(p.ws + WS_X); bf16_t* A = (bf16_t*)(p.ws + WS_A);
    const float gs = ((k == 1) ? 1.0f : 0.5f) * accs;
    unsigned char* A8 = p.ws + WS_A8;
    const float* gate = mod + (size_t)bid * NMODC + (size_t)(3 * k + 2) * D; const float* modn = mod + (size_t)bid * NMODC + (size_t)(3 * (k + 1)) * D;
    const float* g = p.in[I_LNG] + k * D; const float* b = p.in[I_LNB] + k * D;
    f32x4 v[4]; float s = 0.f, s2 = 0.f;
#pragma unroll
    for (int j = 0; j < 4; ++j) {
        const int c = 4 * lane + 256 * j;
        f32x4 a = (f32x4){0.f, 0.f, 0.f, 0.f};
        for (int sidx = 0; sidx < nsplit; ++sidx) a += *(const f32x4*)(slab + ((size_t)sidx * 256 + r) * D + c);
        const u32x2 xr = *(const u32x2*)(Xb + (size_t)row * D + c);
        const f32x4 x = (f32x4){bf_lo(xr.x), bf_hi(xr.x), bf_lo(xr.y), bf_hi(xr.y)};
        const f32x4 g4 = *(const f32x4*)(gate + c);
        v[j] = x * ALPHA + (g4 + 1.0f) * gs * a;
        s += (v[j][0] + v[j][1]) + (v[j][2] + v[j][3]);
    }
    const float mean = wave_sum(s) * (1.0f / D);
#pragma unroll
    for (int j = 0; j < 4; ++j) { v[j] = v[j] - mean; s2 += (v[j][0] * v[j][0] + v[j][1] * v[j][1]) + (v[j][2] * v[j][2] + v[j][3] * v[j][3]); }
    const float rstd = rsqrtf(wave_sum(s2) * (1.0f / D) + LN_EPS);
#pragma unroll
    for (int j = 0; j < 4; ++j) {
        const int c = 4 * lane + 256 * j;
        const f32x4 y = v[j] * rstd * *(const f32x4*)(g + c) + *(const f32x4*)(b + c);
        if (k == 2) *(f32x4*)(p.out + O_Y + (size_t)row * D + c) = y;
        else {
            u32x2 ox; ox.x = cvt_pk_bf16(y[0], y[1]); ox.y = cvt_pk_bf16(y[2], y[3]); *(u32x2*)(Xb + (size_t)row * D + c) = ox;
            const f32x4 a = y * (*(const f32x4*)(modn + D + c) + 1.0f) + *(const f32x4*)(modn + c);
            if (k == 1) *(unsigned*)(A8 + (size_t)row * D + c) = cvt4_fp8(a[0], a[1], a[2], a[3]);
            else { u32x2 oa; oa.x = cvt_pk_bf16(a[0], a[1]); oa.y = cvt_pk_bf16(a[2], a[3]); *(u32x2*)(A + (size_t)row * D + c) = oa; }
        }
    }
}

__device__ __forceinline__ void phase_mixer1(const Params& p, LAS unsigned char* lds, const bool do_sg, const bool do_lru, const int wv) {
    int tid_ = TIDX; asm volatile("" : "+v"(tid_)); const int tid = tid_, lane = tid & 63, w = __builtin_amdgcn_readfirstlane(tid >> 6), fr = lane & 15, fq = lane >> 4;
    LAS unsigned char* vnT = lds;
    LAS float* stats = (LAS float*)(lds + 139264);
    LAS unsigned char* xscr = lds + 143360 + w * 2304;
    const bf16_t* P = (const bf16_t*)(p.ws + WS_P);
    bf16_t* Y = (bf16_t*)(p.ws + WS_Y);
    bf16_t* AC = (bf16_t*)(p.ws + WS_AC);
    const bf16_t* sgw = (const bf16_t*)(p.ws + WS_SGW);
    const bf16_t* lrub = (const bf16_t*)(p.ws + WS_LRUB);
    float* agg = (float*)(p.ws + WS_AGG);
    const int h = w, chD = 64 * h + 4 * fr;
    const f32x4 cw0 = *(const f32x4*)(p.in[I_CONVW] + 0 * 512 + chD), cw1 = *(const f32x4*)(p.in[I_CONVW] + 1 * 512 + chD);
    const f32x4 cw2 = *(const f32x4*)(p.in[I_CONVW] + 2 * 512 + chD), cw3 = *(const f32x4*)(p.in[I_CONVW] + 3 * 512 + chD);
    const f32x4 cb4 = *(const f32x4*)(p.in[I_CONVB] + chD), ba4 = *(const f32x4*)(p.in[I_LBA] + chD), bx4 = *(const f32x4*)(p.in[I_LBX] + chD);
    const f32x4 nba4 = ba4 * -1.4426950408889634f, nbx4 = bx4 * -1.4426950408889634f;
    f32x4 sp4; { const f32x4 lam = *(const f32x4*)(p.in[I_LLAM] + chD);
#pragma unroll
        for (int i = 0; i < 4; ++i) sp4[i] = 8.0f * 1.4426950408889634f * log1pf(expf(-lam[i])); }

    const bool sw16 = gather4_calibrate(fq);
    const int lane_outer = lane;
    for (int q = blockIdx.x; q < NCHUNK; q += gridDim.x) {
        int lane = lane_outer; asm volatile("" : "+v"(lane));
        const int fr = lane & 15, fq = lane >> 4;
        const bool smp = q >= 512;
        const int ntok = smp ? 32 : 128;
        const int row0 = smp ? MP + 32 * (q - 512) : q * 128;
        const int tseq0 = smp ? 0 : (q & 63) * 128;
        if (do_sg) {
            { LAS float* tb = (LAS float*)(lds + 143360); tb[tid] = p.in[I_SGLG][tid]; tb[512 + tid] = p.in[I_SGLB][tid]; }
            const int th = w & 1, g = w >> 1, j = 64 * th + lane;
            const bool valid = j < ntok;
            u32x4 raw[16];
            const bf16_t* src = P + (size_t)(row0 + (valid ? j : 0)) * DIN + 1536 + 128 * g;
            float s = 0.f, ss = 0.f;
#pragma unroll
            for (int c = 0; c < 16; ++c) {
                raw[c] = *(const u32x4*)(src + 8 * c);
#pragma unroll
                for (int e = 0; e < 4; ++e) { const float a = bf_lo(raw[c][e]), b = bf_hi(raw[c][e]); s += a + b; ss += a * a + b * b; }
            }
            stats[(j * 4 + g) * 2 + 0] = s; stats[(j * 4 + g) * 2 + 1] = ss;
            __syncthreads();
            float ts = 0.f, tss = 0.f;
#pragma unroll
            for (int gg = 0; gg < 4; ++gg) { ts += stats[(j * 4 + gg) * 2 + 0]; tss += stats[(j * 4 + gg) * 2 + 1]; }
            const float mean = ts * (1.0f / 512.0f), var = fmaxf(tss * (1.0f / 512.0f) - mean * mean, 0.f), rstd = rsqrtf(var + LN_EPS);
            const float nmr = -mean * rstd;
            const LAS float* lgT = (const LAS float*)(lds + 143360) + 128 * g; const LAS float* lbT = lgT + 512;
#pragma unroll
            for (int c = 0; c < 16; ++c) {
                const f32x4 ga = *(const LAS f32x4*)(lgT + 8 * c), gb = *(const LAS f32x4*)(lgT + 8 * c + 4), ba = *(const LAS f32x4*)(lbT + 8 * c), bb = *(const LAS f32x4*)(lbT + 8 * c + 4);
#pragma unroll
                for (int e = 0; e < 8; ++e) {
                    const unsigned u = raw[c][e >> 1]; const float x = (e & 1) ? bf_hi(u) : bf_lo(u);
                    const int dl = 8 * c + e;
                    float y = (x * rstd + nmr) * (e < 4 ? ga[e] : gb[e - 4]) + (e < 4 ? ba[e] : bb[e - 4]);
                    if (!valid) y = 0.f;
                    *(LAS bf16_t*)(vnT + (128 * g + dl) * 272 + 2 * j) = (bf16_t)(cvt_pk_bf16(y, 0.f) & 0xffffu);
                }
            }
            if (smp) {
                float* ov = p.out + O_SGV + (size_t)((q - 512) * 32 + j) * 512 + 128 * g;
                if (valid) {
#pragma unroll
                    for (int c = 0; c < 16; ++c)
#pragma unroll
                        for (int e = 0; e < 8; ++e) {
                            const unsigned u = raw[c][e >> 1]; const float x = (e & 1) ? bf_hi(u) : bf_lo(u);
                            ov[8 * c + e] = (x - mean) * rstd * lgT[8 * c + e] + lbT[8 * c + e];
                        }
                }
            }
            __syncthreads();
        }
        if (do_sg) {
            const int g = w >> 1, hf = w & 1;
            const LAS unsigned char* afb = vnT + (128 * g + 64 * hf + 16 * (fr >> 2) + (fr & 3)) * 272 + 16 * fq;
            const int nib = ntok >> 4;
            const int chb = 128 * g + 64 * hf + 16 * fq;
            bf16x8 nBf[4]; u32x4 nu0, nu1; float nbias;
#define SG_LOAD(ib_) do { const bf16_t* wb_ = sgw + (size_t)(g * 128 + 16 * (ib_) + fr) * 128 + 8 * fq; \
                _Pragma("unroll") for (int ks = 0; ks < 4; ++ks) nBf[ks] = *(const bf16x8*)(wb_ + 32 * ks);     \
                const size_t row_ = (size_t)row0 + 16 * (ib_) + fr; nbias = p.in[I_SGB][g * 128 + 16 * (ib_) + fr]; \
                nu0 = *(const u32x4*)(P + row_ * DIN + 1024 + chb); nu1 = *(const u32x4*)(P + row_ * DIN + 1024 + chb + 8); } while (0)
            SG_LOAD(0);
            for (int ib = 0; ib < nib; ++ib) {
                f32x4 acc[4];
#pragma unroll
                for (int mb = 0; mb < 4; ++mb) acc[mb] = (f32x4){0.f, 0.f, 0.f, 0.f};
                bf16x8 Bf[4];
#pragma unroll
                for (int ks = 0; ks < 4; ++ks) Bf[ks] = nBf[ks];
                const u32x4 u0 = nu0, u1 = nu1; const float bias = nbias;
                if (ib + 1 < nib) SG_LOAD(ib + 1);
#pragma unroll
                for (int ks = 0; ks < 4; ++ks) {
#pragma unroll
                    for (int mb = 0; mb < 4; ++mb) acc[mb] = __builtin_amdgcn_mfma_f32_16x16x32_bf16(*(const LAS bf16x8*)(afb + mb * 4 * 272 + 64 * ks), Bf[ks], acc[mb], 0, 0, 0);
                }
                const int i = 16 * ib + fr; const size_t row = (size_t)row0 + i;
                float yv[16];
#pragma unroll
                for (int mb = 0; mb < 4; ++mb)
#pragma unroll
                    for (int r = 0; r < 4; ++r) {
                        const int e = mb * 4 + r; const unsigned uu = (e < 8) ? u0[e >> 1] : u1[(e - 8) >> 1];
                        const float us = (e & 1) ? bf_hi(uu) : bf_lo(uu);
                        yv[e] = us * (acc[mb][r] + bias);
                    }
                u32x4 o0, o1;
                o0.x = cvt_pk_bf16(yv[0], yv[1]); o0.y = cvt_pk_bf16(yv[2], yv[3]); o0.z = cvt_pk_bf16(yv[4], yv[5]); o0.w = cvt_pk_bf16(yv[6], yv[7]);
                o1.x = cvt_pk_bf16(yv[8], yv[9]); o1.y = cvt_pk_bf16(yv[10], yv[11]); o1.z = cvt_pk_bf16(yv[12], yv[13]); o1.w = cvt_pk_bf16(yv[14], yv[15]);
                *(u32x4*)(Y + row * D + 512 + chb) = o0; *(u32x4*)(Y + row * D + 512 + chb + 8) = o1;
            }
#undef SG_LOAD
        }
        if (do_lru) {
            float RA[4] = {1.f, 1.f, 1.f, 1.f}, RH[4] = {0.f, 0.f, 0.f, 0.f};
            const int nblk = ntok >> 4;
            const bool lastchunk = smp || ((q & 63) == 63);
            const int lane_q = lane;
            __syncthreads();
            LAS unsigned char* bwl = lds + w * 16384;
#pragma unroll
            for (int hb = 0; hb < 2; ++hb) {
                bf16x8 tb8[8];
#pragma unroll
                for (int i = 0; i < 8; ++i) tb8[i] = *(const bf16x8*)(lrub + ((size_t)(h * 16 + 8 * hb + i) * 64 + lane) * 8);
#pragma unroll
                for (int i = 0; i < 8; ++i) *(LAS bf16x8*)(bwl + (8 * hb + i) * 1024 + lane * 16) = tb8[i];
            }
            u32x2 nxa[7], nga[4];
            u32x2 hv[3];
#pragma unroll
            for (int i = 0; i < 3; ++i) { hv[i].x = 0u; hv[i].y = 0u; }
            if (smp) {
#pragma unroll
                for (int i = 0; i < 3; ++i) { const f32x4 f = *(const f32x4*)(p.in[I_SCONV] + (size_t)((q - 512) * 3 + i) * 512 + chD); hv[i].x = cvt_pk_bf16(f[0], f[1]); hv[i].y = cvt_pk_bf16(f[2], f[3]); }
            }
#define LRU_LOAD(tb_) do { _Pragma("unroll") for (int dr = 0; dr < 7; ++dr) { const int tk = (tb_) + 4 * fq - 3 + dr; const bool pre = (tseq0 + tk) < 0; \
        nxa[dr] = *(const u32x2*)(P + (size_t)(row0 + (pre ? 0 : tk)) * DIN + chD); }   \
        _Pragma("unroll") for (int r = 0; r < 4; ++r) nga[r] = *(const u32x2*)(P + (size_t)(row0 + (tb_) + 4 * fq + r) * DIN + 512 + chD); } while (0)
            LRU_LOAD(0);
            for (int blk = 0; blk < nblk; ++blk) {
                asm volatile("" ::: "memory");
                int lane = lane_q; asm volatile("" : "+v"(lane));
                const int fr = lane & 15, fq = lane >> 4;
                const int tb = 16 * blk;
                float xaf[7][4];
                u32x2 gau[4];
#pragma unroll
                for (int dr = 0; dr < 7; ++dr) {
                    const bool pre = (tseq0 + tb + 4 * fq - 3 + dr) < 0;
                    const unsigned ux = pre ? hv[dr < 3 ? dr : 0].x : nxa[dr].x, uy = pre ? hv[dr < 3 ? dr : 0].y : nxa[dr].y;
                    xaf[dr][0] = bf_lo(ux); xaf[dr][1] = bf_hi(ux); xaf[dr][2] = bf_lo(uy); xaf[dr][3] = bf_hi(uy); }
#pragma unroll
                for (int r = 0; r < 4; ++r) gau[r] = nga[r];
                if (blk + 1 < nblk) LRU_LOAD(tb + 16);
                if (lastchunk && blk == nblk - 1 && fq == 3) {
                    float* oc = smp ? p.out + O_CONVS + (size_t)(q - 512) * 1536 : p.out + O_CONVP + (size_t)(q >> 6) * 1536;
#pragma unroll
                    for (int r = 1; r < 4; ++r) *(f32x4*)(oc + (r - 1) * 512 + chD) = (f32x4){xaf[r + 3][0], xaf[r + 3][1], xaf[r + 3][2], xaf[r + 3][3]};
                }
                float xc[4][4];
#pragma unroll
                for (int r = 0; r < 4; ++r)
#pragma unroll
                    for (int nb = 0; nb < 4; ++nb)
                        xc[r][nb] = cb4[nb] + cw0[nb] * xaf[r][nb] + cw1[nb] * xaf[r + 1][nb] + cw2[nb] * xaf[r + 2][nb] + cw3[nb] * xaf[r + 3][nb];
#pragma unroll
                for (int r = 0; r < 4; ++r) { u32x2 o; o.x = cvt_pk_bf16(xc[r][0], xc[r][1]); o.y = cvt_pk_bf16(xc[r][2], xc[r][3]); *(LAS u32x2*)(xscr + (4 * fq + r) * 144 + 8 * fr) = o; }
                asm volatile("s_waitcnt lgkmcnt(0)" ::: "memory");
                const bf16x8 a0 = *(const LAS bf16x8*)(xscr + fr * 144 + 16 * fq), a1 = *(const LAS bf16x8*)(xscr + fr * 144 + 64 + 16 * fq);
                unsigned y0p[4][2], y1p[4][2];
#pragma unroll
                for (int nbp = 0; nbp < 2; ++nbp) {
                    float y0v[2][4], y1v[2][4];
#pragma unroll
                    for (int nbi = 0; nbi < 2; ++nbi) {
                        const int nb = 2 * nbp + nbi;
                        const bf16x8 b0 = *(const LAS bf16x8*)(bwl + ((0 * 4 + nb) * 2 + 0) * 1024 + lane * 16), b1 = *(const LAS bf16x8*)(bwl + ((0 * 4 + nb) * 2 + 1) * 1024 + lane * 16);
                        const bf16x8 c0 = *(const LAS bf16x8*)(bwl + ((1 * 4 + nb) * 2 + 0) * 1024 + lane * 16), c1 = *(const LAS bf16x8*)(bwl + ((1 * 4 + nb) * 2 + 1) * 1024 + lane * 16);
                        const f32x4 z = (f32x4){0.f, 0.f, 0.f, 0.f};
                        f32x4 racc = __builtin_amdgcn_mfma_f32_16x16x32_bf16(a0, b0, z, 0, 0, 0);
                        racc = __builtin_amdgcn_mfma_f32_16x16x32_bf16(a1, b1, racc, 0, 0, 0);
                        f32x4 iacc = __builtin_amdgcn_mfma_f32_16x16x32_bf16(a0, c0, z, 0, 0, 0);
                        iacc = __builtin_amdgcn_mfma_f32_16x16x32_bf16(a1, c1, iacc, 0, 0, 0);
                        float Ac[4], Hc[4]; float ca = 1.f, ch = 0.f;
#pragma unroll
                        for (int r = 0; r < 4; ++r) {
                            const float rg = __builtin_amdgcn_rcpf(1.0f + fexp2(racc[r] * -1.4426950408889634f + nba4[nb])), ig = __builtin_amdgcn_rcpf(1.0f + fexp2(iacc[r] * -1.4426950408889634f + nbx4[nb]));
                            const float a = fexp2(-sp4[nb] * rg);
                            const float mult = __builtin_amdgcn_sqrtf(__builtin_fmaf(-a, a, 1.0f));
                            const float u = mult * (ig * xc[r][nb]);
                            ca *= a; ch = a * ch + u; Ac[r] = ca; Hc[r] = ch;
                        }
                        const float tA = Ac[3], tH = Hc[3];
                        float A0, A1, A2, A3, H0, H1, H2, H3;
                        gather4(tA, sw16, A0, A1, A2, A3); gather4(tH, sw16, H0, H1, H2, H3);
                        const float pa0 = RA[nb], ph0 = RH[nb];
                        const float pa1 = pa0 * A0, ph1 = A0 * ph0 + H0;
                        const float pa2 = pa1 * A1, ph2 = A1 * ph1 + H1;
                        const float pa3 = pa2 * A2, ph3 = A2 * ph2 + H2;
                        RA[nb] = pa3 * A3; RH[nb] = A3 * ph3 + H3;
                        const float PA = fq == 0 ? pa0 : fq == 1 ? pa1 : fq == 2 ? pa2 : pa3, PH = fq == 0 ? ph0 : fq == 1 ? ph1 : fq == 2 ? ph2 : ph3;
#pragma unroll
                        for (int r = 0; r < 4; ++r) {
                            const unsigned gu = (nb < 2) ? gau[r].x : gau[r].y; const float gav = (nb & 1) ? bf_hi(gu) : bf_lo(gu);
                            const float G = gelu_tanh(gav);
                            y0v[nbi][r] = (Hc[r] + Ac[r] * PH) * G; y1v[nbi][r] = (PA * Ac[r]) * G;
                        }
                    }
#pragma unroll
                    for (int r = 0; r < 4; ++r) { y0p[r][nbp] = cvt_pk_bf16(y0v[0][r], y0v[1][r]); y1p[r][nbp] = cvt_pk_bf16(y1v[0][r], y1v[1][r]); }
                }
#pragma unroll
                for (int r = 0; r < 4; ++r) {
                    const size_t row = (size_t)row0 + tb + 4 * fq + r;
                    u32x2 o; o.x = y0p[r][0]; o.y = y0p[r][1]; *(u32x2*)(Y + row * D + chD) = o;
                    u32x2 o2; o2.x = y1p[r][0]; o2.y = y1p[r][1]; *(u32x2*)(AC + row * 512 + chD) = o2;
                }
            }
            if (fq == 0) {
                *(f32x4*)(agg + (size_t)(q * 2 + 0) * 512 + chD) = (f32x4){RA[0], RA[1], RA[2], RA[3]};
                *(f32x4*)(agg + (size_t)(q * 2 + 1) * 512 + chD) = (f32x4){RH[0], RH[1], RH[2], RH[3]};
            }
        }
        __syncthreads();
    }
}

__device__ __forceinline__ void phase_mixer2(const Params& p, LAS unsigned char* lds, const int wv) {
    int tid_ = TIDX; asm volatile("" : "+v"(tid_)); const int tid = tid_;
    LAS float* carryL = (LAS float*)lds;
    bf16_t* Y = (bf16_t*)(p.ws + WS_Y);
    const bf16_t* AC = (const bf16_t*)(p.ws + WS_AC);
    const float* agg = (const float*)(p.ws + WS_AGG);
    for (int q = blockIdx.x; q < NCHUNK; q += gridDim.x) {
        const bool smp = q >= 512;
        const int ntok = smp ? 32 : 128;
        const int row0 = smp ? MP + 32 * (q - 512) : q * 128;
        float carry;
        if (!smp) {
            const int qb = q & ~63, jc = q & 63; carry = 0.f;
            for (int i0 = 0; i0 < jc; i0 += 8) {
                float Ab[8], Hb[8];
#pragma unroll
                for (int i = 0; i < 8; ++i) { const int qi = qb + ((i0 + i < jc) ? i0 + i : 0); Ab[i] = agg[(size_t)(qi * 2) * 512 + tid]; Hb[i] = agg[(size_t)(qi * 2 + 1) * 512 + tid]; }
#pragma unroll
                for (int i = 0; i < 8; ++i) { const bool on = i0 + i < jc; carry = (on ? Ab[i] : 1.0f) * carry + (on ? Hb[i] : 0.0f); }
            }
        } else carry = p.in[I_SLRU][(q - 512) * 512 + tid];
        if (smp || (q & 63) == 63) {
            const float A = agg[(size_t)(q * 2) * 512 + tid], Hh = agg[(size_t)(q * 2 + 1) * 512 + tid];
            float* dst = smp ? p.out + O_LRUS + (size_t)(q - 512) * 512 : p.out + O_LRUP + (size_t)(q >> 6) * 512;
            dst[tid] = A * carry + Hh;
        }
        carryL[tid] = carry;
        __syncthreads();
        const int c8 = (tid & 63) * 8, rs = tid >> 6;
        float cr[8];
#pragma unroll
        for (int e = 0; e < 8; ++e) cr[e] = carryL[c8 + e];
        for (int r0 = rs; r0 < ntok; r0 += 32) {
            u32x4 a[4], b[4];
#pragma unroll
            for (int i = 0; i < 4; ++i) { const size_t row = (size_t)row0 + r0 + 8 * i; a[i] = *(const u32x4*)(Y + row * D + c8); b[i] = *(const u32x4*)(AC + row * 512 + c8); }
#pragma unroll
            for (int i = 0; i < 4; ++i) {
                const size_t row = (size_t)row0 + r0 + 8 * i; u32x4 o;
#pragma unroll
                for (int e = 0; e < 4; ++e) o[e] = cvt_pk_bf16(bf_lo(a[i][e]) + bf_lo(b[i][e]) * cr[2 * e], bf_hi(a[i][e]) + bf_hi(b[i][e]) * cr[2 * e + 1]);
                *(u32x4*)(Y + row * D + c8) = o;
            }
        }
        __syncthreads();
    }
}

__global__ __launch_bounds__(512, 2) void mega(Params p) {
    extern __shared__ __attribute__((aligned(16))) unsigned char smem[];
    LAS unsigned char* lds = (LAS unsigned char*)smem;
    const int wv = __builtin_amdgcn_readfirstlane((int)(__builtin_amdgcn_workitem_id_x() >> 6));
    cg::grid_group grid = cg::this_grid();
    const float* mod = (const float*)(p.ws + WS_MOD);
    bf16_t* Xb = (bf16_t*)(p.ws + WS_X);
    bf16_t* A = (bf16_t*)(p.ws + WS_A);
    bf16_t* Yb = (bf16_t*)(p.ws + WS_Y);
    unsigned char* H8 = p.ws + WS_H;
    unsigned char* A8 = p.ws + WS_A8;
    bf16_t* Pb = (bf16_t*)(p.ws + WS_P);
    unsigned* barw = (unsigned*)(p.ws + WS_BAR);
    volatile LAS unsigned* bst = (volatile LAS unsigned*)(lds + 161792);
    if (p.nprog < 0) grid.sync();
    if (TIDX == 0) { bst[0] = 0u; bst[1] = 0u; }
    __syncthreads();
    (void)xcd_barrier_post(barw, bst, wv);
    for (int pi = 0; pi < p.nprog; ++pi) {
        const int ph = p.prog[pi];
        switch (ph) {
        #ifndef NO_PREP
        case PH_PREP: phase_prep(p, lds, wv); break;
#endif
        case PH_MOD: phase_mod(p, wv); break;
        case PH_F2: phase_fin(p, 0, 11, 1.0f / (SC_H * SC_W2), wv); break;
        case PH_F4: phase_fin(p, 1, 4, 1.0f, wv); break;
        case PH_F6: phase_fin(p, 2, 11, 1.0f / (SC_H * SC_W2), wv); break;
        case PH_LN0: ln_pass(p.in[I_XP], p.in[I_XS], Xb, A8, p.in[I_LNIG], p.in[I_LNIB], mod, 0, wv); break;
#ifndef NO_G1
        case PH_G1: case PH_G5: {
            pg8::Gemm g{(const bf16_t*)A8, (const bf16_t*)(p.ws + (ph == PH_G1 ? WS_W13A : WS_W13B)), MT, 2 * FF, D / 2};
            pg8::StaticOrder S; S.init(MT, 2 * FF, D / 2, gridDim.x, blockIdx.x);
            pg8::EpiSwiglu E{H8, 1.0f / SC_W13};
            pg8::gemm_phase<true>(lds, g, S, E, wv);
        } break;
#endif
#ifndef NO_G2
        case PH_G2: case PH_G6: {
            pg8::Gemm g{(const bf16_t*)H8, (const bf16_t*)(p.ws + (ph == PH_G2 ? WS_W2A : WS_W2B)), MT, D, FF / 2};
            pg8::PanelOrder S; S.init(FF / 2, gridDim.x, blockIdx.x);
            const int k = ph == PH_G2 ? 0 : 2;
            pg8::EpiResLn E{Xb, ph == PH_G6 ? p.out + O_Y : nullptr, A, nullptr, mod + (size_t)(3 * k + 2) * D, mod + (size_t)(3 * (k + 1)) * D,
                            p.in[I_LNG] + k * D, p.in[I_LNB] + k * D, 0.5f / (SC_H * SC_W2),
                            (unsigned long long*)(p.ws + WS_XBUF), (unsigned*)(p.ws + WS_CNT), ph == PH_G2 ? 32u : 96u};
            pg8::gemm_phase<true>(lds, g, S, E, wv);
            pg8::SubOrder S2; S2.init(FF / 128, 2, gridDim.x, blockIdx.x);
            pg8::EpiSlab E2{(float*)(p.ws + WS_SLAB)};
            pg8::gemm_phase<true>(lds, g, S2, E2, wv);
        } break;
        case PH_G4: {
            pg8::Gemm g{Yb, (const bf16_t*)(p.ws + WS_WOUT), MT, D, D};
            pg8::PanelOrder S; S.init(D, gridDim.x, blockIdx.x);
            pg8::EpiResLn E{Xb, nullptr, nullptr, A8, mod + (size_t)5 * D, mod + (size_t)6 * D, p.in[I_LNG] + D, p.in[I_LNB] + D, 1.0f,
                            (unsigned long long*)(p.ws + WS_XBUF), (unsigned*)(p.ws + WS_CNT), 64u};
            pg8::gemm_phase<false>(lds, g, S, E, wv);
            pg8::SubOrder S2; S2.init(D / 64, 4, gridDim.x, blockIdx.x);
            pg8::EpiSlab E2{(float*)(p.ws + WS_SLAB)};
            pg8::gemm_phase<false>(lds, g, S2, E2, wv);
        } break;
#endif
#ifndef NO_G3
        case PH_G3: {
            pg8::Gemm g{A, (const bf16_t*)(p.ws + WS_WIN), MT, DIN, D};
            pg8::StaticOrder S; S.init(MT, DIN, D, gridDim.x, blockIdx.x);
            pg8::EpiP E{Pb, DIN};
            pg8::gemm_phase<false>(lds, g, S, E, wv);
        } break;
#endif
        #ifndef NO_M1
        case PH_M1: case PH_M1S: case PH_M1L: phase_mixer1(p, lds, ph != PH_M1L, ph != PH_M1S, wv); break;
#endif
        #ifndef NO_M2
        case PH_M2: phase_mixer2(p, lds, wv); break;
#endif
        default: break;
        }
        if (pi + 1 < p.nprog) xcd_barrier(barw, (volatile LAS unsigned*)(lds + 161792), wv);
    }
}

extern "C" void kernel_launch(void* const* d_in, const int* in_sizes, int n_in, void* d_out, int out_size, void* d_ws, size_t ws_size, hipStream_t stream) {
    static int grid_blocks = 0;
    if (grid_blocks == 0) {
        if (n_in != 31 || ws_size < WS_END) { fprintf(stderr, "kernel_launch: unexpected n_in %d or ws_size %zu (< %zu)\n", n_in, ws_size, (size_t)WS_END); grid_blocks = -1; return; }
        int dev = 0, cus = 0, per_cu = 0;
        hipGetDevice(&dev);
        hipDeviceGetAttribute(&cus, hipDeviceAttributeMultiprocessorCount, dev);
        if (hipFuncSetAttribute((const void*)mega, hipFuncAttributeMaxDynamicSharedMemorySize, LDS_BYTES) != hipSuccess) { fprintf(stderr, "kernel_launch: hipFuncSetAttribute failed\n"); grid_blocks = -1; return; }
        hipOccupancyMaxActiveBlocksPerMultiprocessor(&per_cu, (const void*)mega, 512, LDS_BYTES);
        if (per_cu < 1) { fprintf(stderr, "kernel_launch: occupancy query says %d blocks per CU\n", per_cu); per_cu = 1; }
        (void)hipGetLastError();
        grid_blocks = cus * per_cu;
    }
    if (grid_blocks < 0) return;
    Params p{};
    for (int i = 0; i < 31; ++i) p.in[i] = (const float*)d_in[i];
    p.out = (float*)d_out; p.ws = (unsigned char*)d_ws;
#ifndef PROG
#define PROG PH_PREP, PH_LN0, PH_G1, PH_G2, PH_F2, PH_G3, PH_M1, PH_M2, PH_G4, PH_F4, PH_G5, PH_G6, PH_F6
#endif
    { const int prog[] = {PROG}; p.nprog = (int)(sizeof(prog) / sizeof(int)); for (int i = 0; i < p.nprog; ++i) p.prog[i] = prog[i]; }
    if (hipMemsetAsync((char*)d_ws + WS_BAR, 0, WS_ZERO_END - WS_BAR, stream) != hipSuccess) { fprintf(stderr, "kernel_launch: hipMemsetAsync failed\n"); return; }
    void* args[] = {&p};
    hipError_t e = hipLaunchCooperativeKernel((const void*)mega, dim3(grid_blocks), dim3(512), args, LDS_BYTES, stream);
    if (e != hipSuccess) fprintf(stderr, "cooperative launch failed: %s (grid %d)\n", hipGetErrorString(e), grid_blocks);
}
```

```cpp
#include <hip/hip_runtime.h>
#include <hip/hip_cooperative_groups.h>
#include <cstdio>
#include <cstdint>
namespace cg = cooperative_groups;

#define LAS __attribute__((address_space(3)))
__device__ __forceinline__ int lane_id_fresh() { int l; asm volatile("v_mbcnt_lo_u32_b32 %0, -1, 0\n\tv_mbcnt_hi_u32_b32 %0, -1, %0" : "=v"(l)); return l; }
#define TIDX (wv * 64 + lane_id_fresh())
typedef unsigned short bf16_t;
typedef short bf16x8 __attribute__((ext_vector_type(8)));
typedef float f32x4 __attribute__((ext_vector_type(4)));
typedef float f32x2 __attribute__((ext_vector_type(2)));
typedef unsigned u32x4 __attribute__((ext_vector_type(4)));
typedef unsigned u32x2 __attribute__((ext_vector_type(2)));
typedef int v4i __attribute__((ext_vector_type(4)));

constexpr int D = 1024, FF = 2816, MP = 65536, MS = 256, MT = MP + MS, NBID = 16, NMODC = 9 * 1024;
constexpr int DIN = 2048, DLRU = 512, NCHUNK = 520;
constexpr float ALPHA = 1.189207115002721f;
constexpr float LN_EPS = 1e-5f;

constexpr size_t al256(size_t x) { return (x + 255) & ~(size_t)255; }
constexpr size_t WS_BAR = 0;
constexpr size_t WS_CNT = al256(WS_BAR + 3456 * 4);
constexpr size_t WS_MOD = al256(WS_CNT + (size_t)(MT / 256) * 256);
constexpr size_t WS_ZERO_END = al256(WS_MOD + (size_t)NBID * NMODC * 4);
constexpr size_t WS_MODP = WS_ZERO_END;
constexpr size_t WS_W13A = al256(WS_MODP);
constexpr size_t WS_W2A = al256(WS_W13A + (size_t)2 * FF * D * 2);
constexpr size_t WS_W13B = al256(WS_W2A + (size_t)D * FF * 2);
constexpr size_t WS_W2B = al256(WS_W13B + (size_t)2 * FF * D * 2);
constexpr size_t WS_WIN = al256(WS_W2B + (size_t)D * FF * 2);
constexpr size_t WS_WOUT = al256(WS_WIN + (size_t)DIN * D * 2);
constexpr size_t WS_SGW = al256(WS_WOUT + (size_t)D * D * 2);
constexpr size_t WS_LRUB = al256(WS_SGW + (size_t)4 * 128 * 128 * 2);
constexpr size_t WS_AGG = al256(WS_LRUB + (size_t)65536 * 2);
constexpr size_t WS_XBUF = al256(WS_AGG + (size_t)NCHUNK * 2 * 512 * 4);
constexpr size_t WS_SLAB = al256(WS_XBUF + (size_t)MT * 4 * 8);
constexpr size_t WS_X = al256(WS_SLAB + (size_t)11 * 256 * D * 4);
constexpr size_t WS_Y = al256(WS_X + (size_t)MT * D * 2);
constexpr size_t WS_A = al256(WS_Y + (size_t)MT * D * 2);
constexpr size_t WS_A8 = al256(WS_A + (size_t)MT * D * 2);
constexpr size_t WS_H = al256(WS_A8 + (size_t)MT * D);
constexpr size_t WS_P = WS_H;
constexpr size_t WS_AC = al256(WS_P + (size_t)MT * DIN * 2);
constexpr size_t WS_END = al256(WS_H + (size_t)MT * FF * 2);
static_assert(WS_AC + (size_t)MT * 512 * 2 <= WS_END, "AC must fit inside H");

constexpr size_t O_Y = 0;
constexpr size_t O_CONVP = (size_t)MT * D;
constexpr size_t O_LRUP = O_CONVP + 8 * 3 * 512;
constexpr size_t O_CONVS = O_LRUP + 8 * 512;
constexpr size_t O_LRUS = O_CONVS + 8 * 3 * 512;
constexpr size_t O_SGV = O_LRUS + 8 * 512;

constexpr int LDS_BYTES = 161792 + 16;

__device__ __forceinline__ unsigned cvt_pk_bf16(float lo, float hi) { unsigned r; asm("v_cvt_pk_bf16_f32 %0, %1, %2" : "=v"(r) : "v"(lo), "v"(hi)); return r; }
__device__ __forceinline__ unsigned cvt4_fp8(float a, float b, float c, float d) { int p = 0; p = __builtin_amdgcn_cvt_pk_fp8_f32(a, b, p, false); p = __builtin_amdgcn_cvt_pk_fp8_f32(c, d, p, true); return (unsigned)p; }
constexpr float SC_W13 = 256.0f, SC_W2 = 512.0f, SC_H = 8.0f;
__device__ __forceinline__ float lane_read(float v, int src_lane) { return __int_as_float(__builtin_amdgcn_ds_bpermute(src_lane << 2, __float_as_int(v))); }
__device__ __forceinline__ void gather4(float x, bool sw, float& t0, float& t1, float& t2, float& t3) {
    const unsigned xi = __float_as_uint(x);
    const auto r = __builtin_amdgcn_permlane16_swap(xi, xi, false, false);
    const auto a = __builtin_amdgcn_permlane32_swap(r[0], r[0], false, false);
    const auto b = __builtin_amdgcn_permlane32_swap(r[1], r[1], false, false);
    const float e0 = __uint_as_float(a[0]), e2 = __uint_as_float(a[1]), o1 = __uint_as_float(b[0]), o3 = __uint_as_float(b[1]);
    t0 = sw ? o1 : e0; t1 = sw ? e0 : o1; t2 = sw ? o3 : e2; t3 = sw ? e2 : o3;
}
__device__ __forceinline__ bool gather4_calibrate(int fq) {
    float t0, t1, t2, t3; gather4((float)fq, false, t0, t1, t2, t3);
    return __builtin_amdgcn_readfirstlane(__float_as_int(t0)) != 0;
}
__device__ __forceinline__ float bf_lo(unsigned u) { return __uint_as_float(u << 16); }
__device__ __forceinline__ float bf_hi(unsigned u) { return __uint_as_float(u & 0xffff0000u); }
__device__ __forceinline__ float fexp2(float x) { return __builtin_amdgcn_exp2f(x); }
__device__ __forceinline__ float fsigmoid(float x) { return __builtin_amdgcn_rcpf(1.0f + fexp2(-1.4426950408889634f * x)); }
__device__ __forceinline__ float fsilu(float x) { return x * fsigmoid(x); }
__device__ __forceinline__ float gelu_tanh(float x) { const float x2 = x * x; const float t = x * (-2.3022082f + -0.10294324f * x2); return x * __builtin_amdgcn_rcpf(1.0f + fexp2(t)); }
__device__ __forceinline__ int row_bid(int row) { return row < MP ? (row >> 13) : 8 + ((row - MP) >> 5); }
__device__ __forceinline__ float row16_sum(float v) {
    v += __int_as_float(__builtin_amdgcn_update_dpp(0, __float_as_int(v), 0xB1, 0xF, 0xF, true));
    v += __int_as_float(__builtin_amdgcn_update_dpp(0, __float_as_int(v), 0x4E, 0xF, 0xF, true));
    v += __int_as_float(__builtin_amdgcn_update_dpp(0, __float_as_int(v), 0x141, 0xF, 0xF, true));
    v += __int_as_float(__builtin_amdgcn_update_dpp(0, __float_as_int(v), 0x140, 0xF, 0xF, true));
    return v;
}
__device__ __forceinline__ float wave_sum(float v) {
    const int r = __float_as_int(row16_sum(v));
    return (__int_as_float(__builtin_amdgcn_readlane(r, 0)) + __int_as_float(__builtin_amdgcn_readlane(r, 16))) + (__int_as_float(__builtin_amdgcn_readlane(r, 32)) + __int_as_float(__builtin_amdgcn_readlane(r, 48)));
}

namespace pg8 {
constexpr int BM = 256, BK = 64, HALF = 128, HTB = HALF * BK * 2, STAGE_BYTES = 8 * HTB, NXCD = 8, WGM = 8;
__host__ __device__ __forceinline__ int lds_byte(int r, int c) { const int st = (r >> 4) * 2 + (c >> 5), rr = r & 15, cc = c & 31, ob = rr * 64 + cc * 2; return st * 1024 + (ob ^ (((ob >> 9) & 1) << 5)); }
__host__ __device__ __forceinline__ void stage_rc(int b, int& R, int& C) { const int st = b / 1024, sb = b % 1024, swz = sb ^ (((sb >> 9) & 1) << 5); R = (st >> 1) * 16 + swz / 64; C = (st & 1) * 32 + (swz % 64) / 2; }
__host__ __device__ __forceinline__ int perm32(int rho) { const int n = rho >> 4, i = rho & 15; return 8 * (i >> 2) + 4 * n + (i & 3); }
struct Unit { int pm, pn, k0, nt, ks; };
struct Gemm { const bf16_t* A; const bf16_t* Bt; int M, N, K; };
struct StaticOrder {
    int nM, nN, nwg, G, c, ntk;
    __device__ __forceinline__ void init(int M, int N, int K, int G_, int c_) { nM = M / BM; nN = N / BM; nwg = nM * nN; G = G_; c = c_; ntk = K / BK; }
    __device__ __forceinline__ bool next(int i, Unit& u) const {
        const long L = (long)i * G + c; if (L >= nwg) return false;
        int wgid = (int)L; { const int q = nwg / NXCD, r = nwg % NXCD, xcd = wgid % NXCD, off = wgid / NXCD; wgid = (xcd < r ? xcd * (q + 1) : r * (q + 1) + (xcd - r) * q) + off; }
        const int nig = WGM * nN, gid = wgid / nig, fm = gid * WGM, gsz = (nM - fm) < WGM ? (nM - fm) : WGM;
        u.pm = fm + ((wgid % nig) % gsz); u.pn = (wgid % nig) / gsz; u.k0 = 0; u.nt = ntk; u.ks = -1; return true;
    }
};

struct EpiSwiglu {
    static constexpr bool PERM = true;
    unsigned char* H; float sc;
    __device__ __forceinline__ void operator()(const f32x4 (&acc)[2][2][4][2], const Unit& u, int wr, int wc, int fr, int fq, LAS unsigned char*, int, int) const {
        const int row0 = u.pm * BM + wr * 64 + fr, col0 = u.pn * 128 + wc * 32 + 8 * fq;
        float k1 = -1.4426950408889634f * sc, ik2 = 1.0f / (sc * sc * SC_H), lk2 = __builtin_amdgcn_logf(1.0f / (sc * sc * SC_H)); asm volatile("" : "+v"(k1), "+v"(ik2), "+v"(lk2));
#pragma unroll
        for (int ai = 0; ai < 2; ++ai)
#pragma unroll
            for (int m = 0; m < 4; ++m) {
                unsigned char* rowp = H + (size_t)(row0 + ai * HALF + m * 16) * FF + col0;
                float v[8];
#pragma unroll
                for (int n = 0; n < 2; ++n)
#pragma unroll
                    for (int hh = 0; hh < 2; ++hh) {
                        const f32x2 a = (f32x2){acc[ai][0][m][n][2 * hh], acc[ai][0][m][n][2 * hh + 1]}, b = (f32x2){acc[ai][1][m][n][2 * hh], acc[ai][1][m][n][2 * hh + 1]};
                        const f32x2 t = a * k1 + lk2;
                        f32x2 d; d.x = fexp2(t.x); d.y = fexp2(t.y); d = d + ik2;
                        f32x2 r; r.x = __builtin_amdgcn_rcpf(d.x); r.y = __builtin_amdgcn_rcpf(d.y);
                        const f32x2 o = (a * b) * r;
                        v[n * 4 + 2 * hh] = o.x; v[n * 4 + 2 * hh + 1] = o.y;
                    }
                u32x2 w; w.x = cvt4_fp8(v[0], v[1], v[2], v[3]); w.y = cvt4_fp8(v[4], v[5], v[6], v[7]);
                *(u32x2*)rowp = w;
            }
    }
};
struct EpiResLn {
    static constexpr bool PERM = true;
    bf16_t* Xb; float* outY; bf16_t* A; unsigned char* A8; const float* gate; const float* modn; const float* g; const float* b; float gs;
    unsigned long long* xbuf; unsigned* cnt; unsigned want;
    __device__ __forceinline__ void operator()(f32x4 (&acc)[2][2][4][2], const Unit& u, int wr, int wc, int fr, int fq, LAS unsigned char* lds, int wid, int lane) const {
        asm volatile("" : "+v"(fr), "+v"(fq), "+v"(lane));
        float gsl = gs, one = 1.0f, alpha = ALPHA; asm volatile("" : "+v"(gsl), "+v"(one), "+v"(alpha));
        LAS f32x2* Pt = (LAS f32x2*)(lds + 131072);
        LAS f32x2* St = (LAS f32x2*)(lds + 131072 + 8192);
        const int row0 = u.pm * BM + wr * 64 + fr, col0 = u.pn * BM + wc * 32 + 8 * fq;
        const int bid = (u.pm * BM) >> 13;
        {
            const float* gp = gate + (size_t)bid * NMODC + col0;
            f32x4 gq[2][2];
#pragma unroll
            for (int bj = 0; bj < 2; ++bj) { gq[bj][0] = (*(const f32x4*)(gp + bj * HALF) + one) * gsl; gq[bj][1] = (*(const f32x4*)(gp + bj * HALF + 4) + one) * gsl; }
#pragma unroll
            for (int ai = 0; ai < 2; ++ai)
#pragma unroll
                for (int mp = 0; mp < 2; ++mp) {
                    u32x4 xr[2][2];
#pragma unroll
                    for (int mm = 0; mm < 2; ++mm)
#pragma unroll
                        for (int bj = 0; bj < 2; ++bj) xr[mm][bj] = *(const u32x4*)(Xb + (size_t)(row0 + ai * HALF + (2 * mp + mm) * 16) * D + col0 + bj * HALF);
#pragma unroll
                    for (int mm = 0; mm < 2; ++mm)
#pragma unroll
                        for (int bj = 0; bj < 2; ++bj) {
                            const int m = 2 * mp + mm; const u32x4 r = xr[mm][bj];
                            const f32x4 x0 = (f32x4){bf_lo(r.x), bf_hi(r.x), bf_lo(r.y), bf_hi(r.y)}, x1 = (f32x4){bf_lo(r.z), bf_hi(r.z), bf_lo(r.w), bf_hi(r.w)};
                            acc[ai][bj][m][0] = x0 * alpha + gq[bj][0] * acc[ai][bj][m][0];
                            acc[ai][bj][m][1] = x1 * alpha + gq[bj][1] * acc[ai][bj][m][1];
                        }
                    asm volatile("" : "+v"(acc[ai][0][2 * mp][0]), "+v"(acc[ai][0][2 * mp][1]), "+v"(acc[ai][1][2 * mp][0]), "+v"(acc[ai][1][2 * mp][1]));
                    asm volatile("" : "+v"(acc[ai][0][2 * mp + 1][0]), "+v"(acc[ai][0][2 * mp + 1][1]), "+v"(acc[ai][1][2 * mp + 1][0]), "+v"(acc[ai][1][2 * mp + 1][1]));
                    asm volatile("" ::: "memory");
                }
        }
#pragma unroll
        for (int ai = 0; ai < 2; ++ai)
#pragma unroll
            for (int m = 0; m < 4; ++m) {
                float s = 0.f;
#pragma unroll
                for (int bj = 0; bj < 2; ++bj)
#pragma unroll
                    for (int n = 0; n < 2; ++n) { const f32x4 x = acc[ai][bj][m][n]; s += (x[0] + x[1]) + (x[2] + x[3]); }
                s += lane_read(s, lane ^ 16); s += lane_read(s, lane ^ 32);
                const float mw = s * (1.0f / 64.0f); float q = 0.f;
#pragma unroll
                for (int bj = 0; bj < 2; ++bj)
#pragma unroll
                    for (int n = 0; n < 2; ++n) { const f32x4 d = acc[ai][bj][m][n] - mw; q += (d[0] * d[0] + d[1] * d[1]) + (d[2] * d[2] + d[3] * d[3]); }
                q += lane_read(q, lane ^ 16); q += lane_read(q, lane ^ 32);
                if (fq == 0) Pt[(ai * HALF + wr * 64 + m * 16 + fr) * 4 + wc] = (f32x2){mw, q};
            }
        asm volatile("s_waitcnt lgkmcnt(0)" ::: "memory"); __builtin_amdgcn_s_barrier(); asm volatile("" ::: "memory");
        const int prow = wid * 32 + (lane & 31);
        if (lane < 32) {
            const f32x2 a = Pt[prow * 4 + 0], b2 = Pt[prow * 4 + 1], c = Pt[prow * 4 + 2], d = Pt[prow * 4 + 3];
            const float mt = (a.x + b2.x + c.x + d.x) * 0.25f;
            const float da = a.x - mt, db = b2.x - mt, dc = c.x - mt, dd = d.x - mt;
            const float m2 = (a.y + b2.y) + (c.y + d.y) + 64.0f * ((da * da + db * db) + (dc * dc + dd * dd));
            unsigned long long* slot = xbuf + ((size_t)(u.pm * BM + prow) * 4 + u.pn);
            __hip_atomic_store(slot, ((unsigned long long)__float_as_uint(m2) << 32) | __float_as_uint(mt), __ATOMIC_RELAXED, __HIP_MEMORY_SCOPE_AGENT);
        }
        asm volatile("s_waitcnt vmcnt(0)" ::: "memory");
        if (lane == 0) __hip_atomic_fetch_add(cnt + 64 * u.pm, 1u, __ATOMIC_RELAXED, __HIP_MEMORY_SCOPE_AGENT);
        if (wid == 0) {
            unsigned sp = 0;
            while ((unsigned)__builtin_amdgcn_readfirstlane(__hip_atomic_load(cnt + 64 * u.pm, __ATOMIC_RELAXED, __HIP_MEMORY_SCOPE_AGENT)) < want) { __builtin_amdgcn_s_sleep(2); if (++sp > (1u << 22)) break; }
            __builtin_amdgcn_fence(__ATOMIC_ACQUIRE, "agent");
        }
        asm volatile("s_waitcnt vmcnt(0) lgkmcnt(0)" ::: "memory"); __builtin_amdgcn_s_barrier(); asm volatile("" ::: "memory");
        if (lane < 32) {
            const unsigned long long* slot = xbuf + (size_t)(u.pm * BM + prow) * 4; float mt[4], m2[4]; float ms = 0.f;
#pragma unroll
            for (int t = 0; t < 4; ++t) { const unsigned long long w = __hip_atomic_load(slot + t, __ATOMIC_RELAXED, __HIP_MEMORY_SCOPE_AGENT); mt[t] = __uint_as_float((unsigned)w); m2[t] = __uint_as_float((unsigned)(w >> 32)); ms += mt[t]; }
            const float mean = ms * 0.25f; float q = 0.f;
#pragma unroll
            for (int t = 0; t < 4; ++t) { const float dm = mt[t] - mean; q += m2[t] + 256.0f * dm * dm; }
            St[prow] = (f32x2){mean, rsqrtf(q * (1.0f / 1024.0f) + LN_EPS)};
        }
        asm volatile("s_waitcnt lgkmcnt(0)" ::: "memory"); __builtin_amdgcn_s_barrier(); asm volatile("" ::: "memory");
#pragma unroll
        for (int bj = 0; bj < 2; ++bj) {
            const f32x4 gv0 = *(const f32x4*)(g + col0 + bj * HALF), gv1 = *(const f32x4*)(g + col0 + bj * HALF + 4);
            const f32x4 bv0 = *(const f32x4*)(b + col0 + bj * HALF), bv1 = *(const f32x4*)(b + col0 + bj * HALF + 4);
            const float* mb = modn + (size_t)bid * NMODC + col0 + bj * HALF;
            f32x4 sh0, sh1, sc0, sc1;
            if (!outY) { sh0 = *(const f32x4*)(mb); sh1 = *(const f32x4*)(mb + 4); sc0 = *(const f32x4*)(mb + D) + 1.0f; sc1 = *(const f32x4*)(mb + D + 4) + 1.0f; }
#pragma unroll
            for (int ai = 0; ai < 2; ++ai)
#pragma unroll
                for (int m = 0; m < 4; ++m) {
                    const int r = ai * HALF + wr * 64 + m * 16 + fr, row = u.pm * BM + r; const f32x2 sr = St[r];
                    const float nm = -sr.x * sr.y;
                    const f32x4 y0 = (acc[ai][bj][m][0] * sr.y + nm) * gv0 + bv0, y1 = (acc[ai][bj][m][1] * sr.y + nm) * gv1 + bv1;
                    const size_t off = (size_t)row * D + col0 + bj * HALF;
                    if (outY) { *(f32x4*)(outY + off) = y0; *(f32x4*)(outY + off + 4) = y1; }
                    else {
                        u32x4 w; w.x = cvt_pk_bf16(y0[0], y0[1]); w.y = cvt_pk_bf16(y0[2], y0[3]); w.z = cvt_pk_bf16(y1[0], y1[1]); w.w = cvt_pk_bf16(y1[2], y1[3]);
                        *(u32x4*)(Xb + off) = w;
                        {
                            const f32x4 a0 = y0 * sc0 + sh0, a1 = y1 * sc1 + sh1;
                            if (A8) { u32x2 w8; w8.x = cvt4_fp8(a0[0], a0[1], a0[2], a0[3]); w8.y = cvt4_fp8(a1[0], a1[1], a1[2], a1[3]); *(u32x2*)(A8 + off) = w8; }
                            else { u32x4 wa; wa.x = cvt_pk_bf16(a0[0], a0[1]); wa.y = cvt_pk_bf16(a0[2], a0[3]); wa.z = cvt_pk_bf16(a1[0], a1[1]); wa.w = cvt_pk_bf16(a1[2], a1[3]); *(u32x4*)(A + off) = wa; }
                        }
                    }
                    if (m & 1) asm volatile("" ::: "memory");
                }
        }
    }
};
struct PanelOrder {
    int nwg, G, vc, ntk;
    __device__ __forceinline__ void init(int K, int G_, int c_) { ntk = K / BK; nwg = (MP / BM) * 4; G = G_; vc = (c_ & 7) * (G_ >> 3) + (c_ >> 3); }
    __device__ __forceinline__ bool next(int i, Unit& u) const { const int L = i * G + vc; if (L >= nwg) return false; u.pm = L >> 2; u.pn = L & 3; u.k0 = 0; u.nt = ntk; u.ks = -1; return true; }
};
struct SubOrder {
    int n, vc, nts;
    __device__ __forceinline__ void init(int ntk, int slice, int G_, int c_) { n = 4 * (ntk / slice); vc = (c_ & 7) * (G_ >> 3) + (c_ >> 3); asm volatile("" : "+s"(slice)); nts = slice; }
    __device__ __forceinline__ bool next(int i, Unit& u) const { if (i > 0 || vc >= n) return false; u.pm = MP / BM; u.pn = vc & 3; u.ks = vc >> 2; u.k0 = nts * (vc >> 2); u.nt = nts; return true; }
};
struct EpiSlab {
    static constexpr bool PERM = true;
    float* slab;
    __device__ __forceinline__ void operator()(const f32x4 (&acc)[2][2][4][2], const Unit& u, int wr, int wc, int fr, int fq, LAS unsigned char*, int, int) const {
        float* sp = slab + ((size_t)u.ks * 256 + wr * 64 + fr) * D + u.pn * BM + wc * 32 + 8 * fq;
#pragma unroll
        for (int ai = 0; ai < 2; ++ai)
#pragma unroll
            for (int m = 0; m < 4; ++m)
#pragma unroll
                for (int bj = 0; bj < 2; ++bj) { float* q = sp + (size_t)(ai * HALF + m * 16) * D + bj * HALF; *(f32x4*)q = acc[ai][bj][m][0]; *(f32x4*)(q + 4) = acc[ai][bj][m][1]; }
    }
};
struct EpiP {
    static constexpr bool PERM = true;
    bf16_t* O; int ldc;
    __device__ __forceinline__ void operator()(const f32x4 (&acc)[2][2][4][2], const Unit& u, int wr, int wc, int fr, int fq, LAS unsigned char*, int, int) const {
        const int row0 = u.pm * BM + wr * 64 + fr, col0 = u.pn * BM + wc * 32 + 8 * fq;
#pragma unroll
        for (int ai = 0; ai < 2; ++ai)
#pragma unroll
            for (int m = 0; m < 4; ++m) {
                bf16_t* rowp = O + (size_t)(row0 + ai * HALF + m * 16) * ldc + col0;
#pragma unroll
                for (int bj = 0; bj < 2; ++bj) {
                    const f32x4 v0 = acc[ai][bj][m][0], v1 = acc[ai][bj][m][1];
                    u32x4 w; w.x = cvt_pk_bf16(v0[0], v0[1]); w.y = cvt_pk_bf16(v0[2], v0[3]); w.z = cvt_pk_bf16(v1[0], v1[1]); w.w = cvt_pk_bf16(v1[2], v1[3]);
                    *(u32x4*)(rowp + bj * HALF) = w;
                }
            }
    }
};

template <bool FP8, class Epi, class Sched>
__device__ __forceinline__ void gemm_phase(LAS unsigned char* lds, const Gemm g, const Sched& S, const Epi& E, const int wv) {
    int tid_ = TIDX; asm volatile("" : "+v"(tid_)); const int tid = tid_, wid = __builtin_amdgcn_readfirstlane(tid >> 6), lane = tid & 63, wr = wid >> 2, wc = wid & 3, fr = lane & 15, fq = lane >> 4;
    const int K = g.K;
    unsigned voffA[2], voffB[2];
#pragma unroll
    for (int i = 0; i < 2; ++i) { int R, C; stage_rc(tid * 16 + i * 8192, R, C); const int Rb = Epi::PERM ? ((R & ~31) + perm32(R & 31)) : R;
        voffA[i] = (unsigned)(R * K + C) * 2u; voffB[i] = (unsigned)(Rb * K + C) * 2u; }
    const unsigned kstep = (unsigned)(BK * 2);
    const unsigned hstep = (unsigned)HALF * (unsigned)K * 2u;
    const unsigned tstep = 2u * hstep;
    const __amdgpu_buffer_rsrc_t rA = __builtin_amdgcn_make_buffer_rsrc((void*)g.A, (short)0, 0x7ffffff0, 0x00020000);
    const __amdgpu_buffer_rsrc_t rB = __builtin_amdgcn_make_buffer_rsrc((void*)g.Bt, (short)0, 0x7ffffff0, 0x00020000);
    const unsigned ldsw = (unsigned)wid * 1024u;
    const int aoff = lds_byte(wr * 64 + fr, fq * 8), boff = lds_byte(wc * 32 + fr, fq * 8);
#define PG8_SA(b, h) (((b) * 2 + (h)) * HTB)
#define PG8_SB(b, h) ((4 + (b) * 2 + (h)) * HTB)
#define PG8_STAGE(bufoff, rsrc, soff, voff) do { _Pragma("unroll") for (int _i = 0; _i < 2; ++_i) \
        __builtin_amdgcn_raw_ptr_buffer_load_lds(rsrc, (LAS void*)(lds + (bufoff) + ldsw + _i * 8192), 16, (voff)[_i], (soff), 0, 0); } while (0)
#define PG8_LDA(dst, b, h) do { _Pragma("unroll") for (int m = 0; m < 4; ++m) _Pragma("unroll") for (int k = 0; k < 2; ++k) dst[m][k] = *(const LAS bf16x8*)(lds + PG8_SA(b, h) + aoff + m * 2048 + k * 1024); } while (0)
#define PG8_LDB(dst, b, h) do { _Pragma("unroll") for (int n = 0; n < 2; ++n) _Pragma("unroll") for (int k = 0; k < 2; ++k) dst[n][k] = *(const LAS bf16x8*)(lds + PG8_SB(b, h) + boff + n * 2048 + k * 1024); } while (0)
#define PG8_MMA(ai, bj, At, Bt) do { __builtin_amdgcn_s_setprio(1); _Pragma("unroll") for (int m = 0; m < 4; ++m) _Pragma("unroll") for (int n = 0; n < 2; ++n) { \
        if constexpr (FP8) { acc[ai][bj][m][n] = __builtin_amdgcn_mfma_scale_f32_16x16x128_f8f6f4(__builtin_shufflevector((v4i)Bt[n][0], (v4i)Bt[n][1], 0, 1, 2, 3, 4, 5, 6, 7), \
                                 __builtin_shufflevector((v4i)At[m][0], (v4i)At[m][1], 0, 1, 2, 3, 4, 5, 6, 7), acc[ai][bj][m][n], 0, 0, 0, 0, 0, 0); } \
        else { _Pragma("unroll") for (int k = 0; k < 2; ++k) acc[ai][bj][m][n] = __builtin_amdgcn_mfma_f32_16x16x32_bf16(Bt[n][k], At[m][k], acc[ai][bj][m][n], 0, 0, 0); } } \
        __builtin_amdgcn_s_setprio(0); } while (0)
#define PG8_WAIT_V(n) asm volatile("s_waitcnt vmcnt(" #n ")" ::: "memory")
#define PG8_WAIT_L(n) asm volatile("s_waitcnt lgkmcnt(" #n ")" ::: "memory")
#define PG8_BAR __builtin_amdgcn_s_barrier()
#define PG8_SCHED __builtin_amdgcn_sched_barrier(0)
    Unit cur, nxt; int ui = 0;
    if (!S.next(0, cur)) return;
    f32x4 acc[2][2][4][2];
#pragma unroll
    for (int a = 0; a < 2; ++a)
#pragma unroll
        for (int b = 0; b < 2; ++b)
#pragma unroll
            for (int m = 0; m < 4; ++m)
#pragma unroll
                for (int n = 0; n < 2; ++n) acc[a][b][m][n] = (f32x4){0.f, 0.f, 0.f, 0.f};
    bf16x8 At[4][2], B0[2][2], B1[2][2];
    unsigned cA = (unsigned)cur.pm * tstep + (unsigned)cur.k0 * kstep, cB = (unsigned)cur.pn * tstep + (unsigned)cur.k0 * kstep;
    PG8_STAGE(PG8_SB(0, 0), rB, cB, voffB); PG8_STAGE(PG8_SB(0, 1), rB, cB + hstep, voffB); PG8_STAGE(PG8_SA(0, 0), rA, cA, voffA); PG8_STAGE(PG8_SA(0, 1), rA, cA + hstep, voffA);
    if (wr == 1) PG8_BAR;
    PG8_WAIT_V(2); PG8_BAR;
    PG8_STAGE(PG8_SB(1, 0), rB, cB + kstep, voffB); PG8_STAGE(PG8_SA(1, 0), rA, cA + kstep, voffA); PG8_STAGE(PG8_SB(1, 1), rB, cB + hstep + kstep, voffB);
    PG8_WAIT_V(6); PG8_BAR;
    for (;;) {
        const bool has_next = S.next(ui + 1, nxt);
        const unsigned nA = has_next ? (unsigned)nxt.pm * tstep + (unsigned)nxt.k0 * kstep : cA, nB = has_next ? (unsigned)nxt.pn * tstep + (unsigned)nxt.k0 * kstep : cB;
        const int nt = cur.nt;
        for (int t = 0; t < nt; t += 2) {
            const bool last = (t == nt - 2);
            const unsigned a1 = cA + (unsigned)(t + 1) * kstep;
            const unsigned a2 = last ? nA : cA + (unsigned)(t + 2) * kstep, b2 = last ? nB : cB + (unsigned)(t + 2) * kstep;
            const unsigned a3 = a2 + kstep, b3 = b2 + kstep;
            PG8_LDB(B0, 0, 0); PG8_LDB(B1, 0, 1); PG8_SCHED; PG8_LDA(At, 0, 0); PG8_STAGE(PG8_SA(1, 1), rA, a1 + hstep, voffA);
            PG8_WAIT_V(8); PG8_WAIT_L(0); PG8_BAR; PG8_MMA(0, 0, At, B0); PG8_MMA(0, 1, At, B1); PG8_BAR; PG8_SCHED;
            PG8_LDA(At, 0, 1); PG8_STAGE(PG8_SB(0, 0), rB, b2, voffB); PG8_STAGE(PG8_SB(0, 1), rB, b2 + hstep, voffB); PG8_STAGE(PG8_SA(0, 0), rA, a2, voffA);
            PG8_WAIT_V(8); PG8_WAIT_L(0); PG8_BAR; PG8_MMA(1, 0, At, B0); PG8_MMA(1, 1, At, B1); PG8_BAR; PG8_SCHED;
            PG8_LDB(B0, 1, 0); PG8_LDB(B1, 1, 1); PG8_SCHED; PG8_LDA(At, 1, 0); PG8_STAGE(PG8_SA(0, 1), rA, a2 + hstep, voffA);
            PG8_WAIT_V(8); PG8_WAIT_L(0); PG8_BAR; PG8_MMA(0, 0, At, B0); PG8_MMA(0, 1, At, B1); PG8_BAR; PG8_SCHED;
            PG8_LDA(At, 1, 1); PG8_STAGE(PG8_SB(1, 0), rB, b3, voffB); PG8_STAGE(PG8_SB(1, 1), rB, b3 + hstep, voffB); PG8_STAGE(PG8_SA(1, 0), rA, a3, voffA);
            PG8_WAIT_V(8); PG8_WAIT_L(0); PG8_BAR; PG8_MMA(1, 0, At, B0); PG8_MMA(1, 1, At, B1); PG8_BAR; PG8_SCHED;
        }
        if (wr == 0) PG8_BAR;
        { const int l2 = lane_id_fresh(); E(acc, cur, wr, wc, l2 & 15, l2 >> 4, lds, wid, l2); }
        if (!has_next) break;
#pragma unroll
        for (int a = 0; a < 2; ++a)
#pragma unroll
            for (int b = 0; b < 2; ++b)
#pragma unroll
                for (int m = 0; m < 4; ++m)
#pragma unroll
                    for (int n = 0; n < 2; ++n) acc[a][b][m][n] = (f32x4){0.f, 0.f, 0.f, 0.f};
        cur = nxt; cA = nA; cB = nB; ++ui;
        if (wr == 1) PG8_BAR;
    }
    PG8_WAIT_V(0);
    PG8_BAR;
#undef PG8_SA
#undef PG8_SB
#undef PG8_STAGE
#undef PG8_LDA
#undef PG8_LDB
#undef PG8_MMA
#undef PG8_WAIT_V
#undef PG8_WAIT_L
#undef PG8_BAR
#undef PG8_SCHED
}
}

#define XB_TMO      128
#define XB_XCNT(j)  (256  + 64 * (j))
#define XB_XSUB(j)  (1280 + 64 * (j))
#define XB_XGEN(j)  (2304 + 64 * (j))
#define XB_TOP      3328
#define XB_TOPGEN   3392
#define XCD_BAR_WORDS 3456
#define XB_SPIN_CAP (1u << 22)
__device__ __forceinline__ unsigned xb_ld(unsigned* p)              { return __hip_atomic_load(p, __ATOMIC_RELAXED, __HIP_MEMORY_SCOPE_AGENT); }
__device__ __forceinline__ unsigned xb_add(unsigned* p, unsigned v) { return __hip_atomic_fetch_add(p, v, __ATOMIC_RELAXED, __HIP_MEMORY_SCOPE_AGENT); }
__device__ __forceinline__ unsigned xb_xcc_id() { return (unsigned)__builtin_amdgcn_s_getreg((3 << 11) | 20) & 0xFu; }
#define XB_SPIN(cond, bar) do { unsigned _sp = 0; while (cond) { __builtin_amdgcn_s_sleep(1); \
    if ((++_sp & 255u) == 0u) { if (xb_ld(&(bar)[XB_TMO])) break; if (_sp > XB_SPIN_CAP) { atomicAdd(&(bar)[XB_TMO], 1u); break; } } } } while (0)
struct XcdBarrier { unsigned* bar; unsigned x; volatile LAS unsigned* st; };
__device__ __forceinline__ XcdBarrier xcd_barrier_post(unsigned* bar, volatile LAS unsigned* st, const int wv) {
    XcdBarrier b; b.bar = bar; b.x = xb_xcc_id(); b.st = st;
    if (TIDX == 0) (void)xb_add(&bar[XB_XCNT(b.x)], 1u);
    return b;
}
__device__ __forceinline__ void xcd_barrier_complete(unsigned* bar, unsigned x, unsigned& nloc, unsigned& nx) {
    const unsigned G = gridDim.x * gridDim.y * gridDim.z;
    unsigned sum, cnt, mine, sp = 0u;
    for (;;) {
        sum = 0u; cnt = 0u; mine = 0u;
#pragma unroll
        for (unsigned j = 0; j < 16; ++j) { const unsigned c = xb_ld(&bar[XB_XCNT(j)]); sum += c; cnt += (c > 0u) ? 1u : 0u; mine = (j == x) ? c : mine; }
        if (sum == G) break;
        __builtin_amdgcn_s_sleep(1);
        if ((++sp & 255u) == 0u) { if (xb_ld(&bar[XB_TMO])) break; if (sp > XB_SPIN_CAP) { atomicAdd(&bar[XB_TMO], 1u); break; } }
    }
    nloc = mine > 0u ? mine : 1u; nx = cnt > 0u ? cnt : 1u;
}
__device__ __forceinline__ void xcd_barrier(unsigned* const barp, volatile LAS unsigned* const stp, const int wv) {
    XcdBarrier b; b.bar = barp; b.st = stp; b.x = xb_xcc_id();
    asm volatile("s_waitcnt vmcnt(0)" ::: "memory");
    __syncthreads();
    if (TIDX == 0) {
        unsigned* bar = b.bar;
        __builtin_amdgcn_s_waitcnt(0);
        unsigned nloc = b.st[0], nx = b.st[1];
        if (nloc == 0u) { xcd_barrier_complete(bar, b.x, nloc, nx); b.st[0] = nloc; b.st[1] = nx; }
        const unsigned old = xb_add(&bar[XB_XSUB(b.x)], 1u);
        const unsigned gen = old / nloc;
        if (old + 1u == (gen + 1u) * nloc) {
            __builtin_amdgcn_fence(__ATOMIC_RELEASE, "agent");
            asm volatile("s_waitcnt vmcnt(0)" ::: "memory");
            const unsigned og = xb_add(&bar[XB_TOP], 1u);
            const unsigned tg = og / nx;
            if (og + 1u == (tg + 1u) * nx) xb_add(&bar[XB_TOPGEN], 1u);
            else XB_SPIN(xb_ld(&bar[XB_TOPGEN]) == tg, bar);
            __builtin_amdgcn_fence(__ATOMIC_ACQUIRE, "agent");
            xb_add(&bar[XB_XGEN(b.x)], 1u);
            asm volatile("s_waitcnt vmcnt(0)" ::: "memory");
        } else {
            XB_SPIN(xb_ld(&bar[XB_XGEN(b.x)]) == gen, bar);
            __builtin_amdgcn_fence(__ATOMIC_ACQUIRE, "agent");
            asm volatile("s_waitcnt vmcnt(0)" ::: "memory");
        }
    }
    __syncthreads();
}

struct Params {
    const float* in[31];
    float* out;
    unsigned char* ws;
    int nprog;
    int prog[27];
};
enum { I_XP = 0, I_XS, I_CP, I_CS, I_SCONV, I_SLRU, I_LNIG, I_LNIB, I_WADA, I_BADA, I_LNG, I_LNB, I_F1W1, I_F1W3, I_F1W2, I_F2W1, I_F2W3, I_F2W2,
       I_WIN, I_WOUT, I_CONVW, I_CONVB, I_LWA, I_LBA, I_LWX, I_LBX, I_LLAM, I_SGLG, I_SGLB, I_SGW, I_SGB };
enum { PH_PREP = 0, PH_MOD, PH_LN0, PH_G1, PH_G2, PH_LN1, PH_G3, PH_M1, PH_M2, PH_G4, PH_LN2, PH_G5, PH_G6, PH_LN3, PH_COUNT, PH_M1S, PH_M1L, PH_F2, PH_F4, PH_F6 };

__device__ __forceinline__ void transpose_item(const float* W, int K, int N, bf16_t* WT, int k0, int n0, int drow0, LAS float* scr, int lane) {
#pragma unroll
    for (int hh = 0; hh < 2; ++hh) {
        float tv[16];
#pragma unroll
        for (int i = 0; i < 16; ++i) tv[i] = W[(size_t)(k0 + 2 * (16 * hh + i) + (lane >> 5)) * N + n0 + (lane & 31)];
#pragma unroll
        for (int i = 0; i < 16; ++i) scr[(2 * (16 * hh + i) + (lane >> 5)) * 33 + (lane & 31)] = tv[i];
    }
    asm volatile("s_waitcnt lgkmcnt(0)" ::: "memory");
    const int c = lane & 7;
#pragma unroll
    for (int j = 0; j < 4; ++j) { const int n = (lane >> 3) + 8 * j; const LAS float* s = scr + (8 * c) * 33 + n;
        u32x4 o; o.x = cvt_pk_bf16(s[0 * 33], s[1 * 33]); o.y = cvt_pk_bf16(s[2 * 33], s[3 * 33]); o.z = cvt_pk_bf16(s[4 * 33], s[5 * 33]); o.w = cvt_pk_bf16(s[6 * 33], s[7 * 33]);
        *(u32x4*)(WT + (size_t)(drow0 + n) * K + k0 + 8 * c) = o; }
    asm volatile("s_waitcnt lgkmcnt(0)" ::: "memory");
}

__device__ __forceinline__ void transpose_item_f8(const float* W, int K, int N, unsigned char* WT, int k0, int n0, int drow0, float scale, LAS float* scr, int lane) {
#pragma unroll
    for (int hh = 0; hh < 2; ++hh) {
        float tv[16];
#pragma unroll
        for (int i = 0; i < 16; ++i) tv[i] = W[(size_t)(k0 + 2 * (16 * hh + i) + (lane >> 5)) * N + n0 + (lane & 31)];
#pragma unroll
        for (int i = 0; i < 16; ++i) scr[(2 * (16 * hh + i) + (lane >> 5)) * 33 + (lane & 31)] = tv[i] * scale;
    }
    asm volatile("s_waitcnt lgkmcnt(0)" ::: "memory");
#pragma unroll
    for (int t = 0; t < 2; ++t) { const int i = lane + 64 * t, n = i >> 2, c = i & 3; const LAS float* s = scr + (16 * c) * 33 + n;
        u32x4 o;
        o.x = cvt4_fp8(s[0 * 33], s[1 * 33], s[2 * 33], s[3 * 33]); o.y = cvt4_fp8(s[4 * 33], s[5 * 33], s[6 * 33], s[7 * 33]);
        o.z = cvt4_fp8(s[8 * 33], s[9 * 33], s[10 * 33], s[11 * 33]); o.w = cvt4_fp8(s[12 * 33], s[13 * 33], s[14 * 33], s[15 * 33]);
        *(u32x4*)(WT + (size_t)(drow0 + n) * K + k0 + 16 * c) = o; }
    asm volatile("s_waitcnt lgkmcnt(0)" ::: "memory");
}

__device__ __forceinline__ void phase_prep(const Params& p, LAS unsigned char* lds, const int wv) {
    int tid_ = TIDX; asm volatile("" : "+v"(tid_)); const int tid = tid_, lane = tid & 63, w = __builtin_amdgcn_readfirstlane(tid >> 6);
    const int gw = blockIdx.x * 8 + w, NGW = gridDim.x * 8;
    LAS float* scr = (LAS float*)(lds + w * 8448);
    unsigned char* W13A = p.ws + WS_W13A; unsigned char* W2A = p.ws + WS_W2A; unsigned char* W13B = p.ws + WS_W13B; unsigned char* W2B = p.ws + WS_W2B;
    bf16_t* WIN = (bf16_t*)(p.ws + WS_WIN); bf16_t* WOUT = (bf16_t*)(p.ws + WS_WOUT);
    constexpr int I13 = (D / 64) * (FF / 32);
    constexpr int I2 = (FF / 64) * (D / 32);
    constexpr int IIN = (D / 64) * (DIN / 32);
    constexpr int IOUT = (D / 64) * (D / 32);
    constexpr int NTR = 4 * I13 + 2 * I2 + IIN + IOUT;
    constexpr int NMODT = 144 * 16;
    for (int it = gw; it < NTR + NMODT; it += NGW) {
        int r = it;
        if (r < 4 * I13) {
            const int mat = r / I13; r -= mat * I13;
            const int nblk = FF / 32, kb = r / nblk, nb = r % nblk, n0 = 32 * nb;
            const float* W = p.in[mat == 0 ? I_F1W1 : mat == 1 ? I_F1W3 : mat == 2 ? I_F2W1 : I_F2W3];
            unsigned char* WT = (mat < 2) ? W13A : W13B;
            const int drow0 = 256 * (n0 >> 7) + (n0 & 127) + ((mat & 1) ? 128 : 0);
            transpose_item_f8(W, D, FF, WT, 64 * kb, n0, drow0, SC_W13, scr, lane);
            continue;
        }
        r -= 4 * I13;
        if (r < 2 * I2) {
            const int mat = r / I2; r -= mat * I2;
            const int nblk = D / 32, kb = r / nblk, nb = r % nblk;
            transpose_item_f8(p.in[mat ? I_F2W2 : I_F1W2], FF, D, mat ? W2B : W2A, 64 * kb, 32 * nb, 32 * nb, SC_W2, scr, lane);
            continue;
        }
        r -= 2 * I2;
        if (r < IIN) { const int nblk = DIN / 32, kb = r / nblk, nb = r % nblk; transpose_item(p.in[I_WIN], D, DIN, WIN, 64 * kb, 32 * nb, 32 * nb, scr, lane); continue; }
        r -= IIN;
        if (r < IOUT) { const int nblk = D / 32, kb = r / nblk, nb = r % nblk; transpose_item(p.in[I_WOUT], D, D, WOUT, 64 * kb, 32 * nb, 32 * nb, scr, lane); continue; }
        r -= IOUT;
        {
            const int cgp = r >> 4, ks = r & 15, n = 64 * cgp + lane, k0 = 64 * ks;
            float sil[16], acc[16];
#pragma unroll
            for (int b = 0; b < 16; ++b) { const float cv = (b < 8) ? p.in[I_CP][b * D + k0 + lane] : p.in[I_CS][(b - 8) * D + k0 + lane]; sil[b] = fsilu(cv); acc[b] = 0.f; }
            const float* wa = p.in[I_WADA] + (size_t)k0 * NMODC + n;
#pragma unroll 8
            for (int kk = 0; kk < 64; ++kk) {
                const float wv_ = wa[(size_t)kk * NMODC];
#pragma unroll
                for (int b = 0; b < 16; ++b) acc[b] += __int_as_float(__builtin_amdgcn_readlane(__float_as_int(sil[b]), kk)) * wv_;
            }
            float* mp = (float*)(p.ws + WS_MOD);
            const float bias = (ks == 0) ? p.in[I_BADA][n] : 0.f;
#pragma unroll
            for (int b = 0; b < 16; ++b) atomicAdd(mp + (size_t)b * NMODC + n, acc[b] + bias);
        }
    }
    const int gt = blockIdx.x * 512 + tid, NGT = gridDim.x * 512;
    bf16_t* sgw = (bf16_t*)(p.ws + WS_SGW);
    for (int i = gt; i < 65536; i += NGT) { const int ii = (i >> 7) & 127, jj = i & 127; const float v = (jj <= ii) ? p.in[I_SGW][i] : 0.f; sgw[i] = (bf16_t)(cvt_pk_bf16(v, 0.f) & 0xffffu); }
    bf16_t* lrub = (bf16_t*)(p.ws + WS_LRUB);
    for (int i = gt; i < 65536; i += NGT) {
        const int j = i & 7, ln = (i >> 3) & 63, ks = (i >> 9) & 1, nb = (i >> 10) & 3, mat = (i >> 12) & 1, h = i >> 13;
        const int fr = ln & 15, fq = ln >> 4, k = 32 * ks + 8 * fq + j, n = 4 * fr + nb;
        const float v = p.in[mat ? I_LWX : I_LWA][(h * 64 + k) * 64 + n];
        lrub[i] = (bf16_t)(cvt_pk_bf16(v, 0.f) & 0xffffu);
    }
}

__device__ __forceinline__ void phase_mod(const Params& p, const int wv) {
    int tid_ = TIDX; asm volatile("" : "+v"(tid_)); const int gt = blockIdx.x * 512 + tid_, NGT = gridDim.x * 512;
    const float* mp = (const float*)(p.ws + WS_MODP); float* mod = (float*)(p.ws + WS_MOD);
    for (int i = gt; i < NBID * NMODC; i += NGT) {
        const int b = i / NMODC, n = i - b * NMODC; float s = p.in[I_BADA][n];
#pragma unroll
        for (int ks = 0; ks < 16; ++ks) s += mp[(size_t)(ks * 16 + b) * NMODC + n];
        mod[i] = s;
    }
}

__device__ __forceinline__ void ln_pass(const float* srcP, const float* srcS, bf16_t* dstX, unsigned char* dstA8, const float* g, const float* b, const float* mod, int kmod, const int wv) {
    int tid_ = TIDX; asm volatile("" : "+v"(tid_)); const int tid = tid_, lane = tid & 63, w = __builtin_amdgcn_readfirstlane(tid >> 6);
    const int gw = blockIdx.x * 8 + w, NGW = gridDim.x * 8;
    f32x4 gv[4], bv[4];
#pragma unroll
    for (int j = 0; j < 4; ++j) { gv[j] = *(const f32x4*)(g + 4 * lane + 256 * j); bv[j] = *(const f32x4*)(b + 4 * lane + 256 * j); }
    f32x4 nv[2][4], shv[2][4], scv[2][4]; int cbid[2] = {-1, -1};
#define LN_LOAD(dst, rowa_) do { _Pragma("unroll") for (int t = 0; t < 2; ++t) { const int row = (rowa_) + t * NGW; if (row < MT) { \
        const float* xr = (row >= MP) ? srcS + (size_t)(row - MP) * D : srcP + (size_t)row * D; \
        _Pragma("unroll") for (int j = 0; j < 4; ++j) dst[t][j] = *(const f32x4*)(xr + 4 * lane + 256 * j); } } } while (0)
    LN_LOAD(nv, gw);
    for (int rowa = gw; rowa < MT; rowa += 2 * NGW) {
        f32x4 v[2][4]; float s[2], s2[2];
#pragma unroll
        for (int t = 0; t < 2; ++t)
#pragma unroll
            for (int j = 0; j < 4; ++j) v[t][j] = nv[t][j];
        if (rowa + 2 * NGW < MT) LN_LOAD(nv, rowa + 2 * NGW);
#pragma unroll
        for (int t = 0; t < 2; ++t) {
            float a = 0.f, q = 0.f;
#pragma unroll
            for (int j = 0; j < 4; ++j) { a += (v[t][j][0] + v[t][j][1]) + (v[t][j][2] + v[t][j][3]); q += (v[t][j][0] * v[t][j][0] + v[t][j][1] * v[t][j][1]) + (v[t][j][2] * v[t][j][2] + v[t][j][3] * v[t][j][3]); }
            s[t] = a; s2[t] = q;
        }
#pragma unroll
        for (int t = 0; t < 2; ++t) {
            const int row = rowa + t * NGW;
            if (row < MT) {
                const float mean = wave_sum(s[t]) * (1.0f / D);
                const float var = fmaxf(wave_sum(s2[t]) * (1.0f / D) - mean * mean, 0.f);
                const float rstd = rsqrtf(var + LN_EPS);
                const int bid = row_bid(row);
                if (bid != cbid[t]) {
                    cbid[t] = bid; const float* mb = mod + (size_t)bid * NMODC + (size_t)(3 * kmod) * D;
#pragma unroll
                    for (int j = 0; j < 4; ++j) { shv[t][j] = *(const f32x4*)(mb + 4 * lane + 256 * j); scv[t][j] = *(const f32x4*)(mb + D + 4 * lane + 256 * j) + 1.0f; }
                }
#pragma unroll
                for (int j = 0; j < 4; ++j) {
                    const f32x4 y = (v[t][j] - mean) * rstd * gv[j] + bv[j];
                    u32x2 ox; ox.x = cvt_pk_bf16(y[0], y[1]); ox.y = cvt_pk_bf16(y[2], y[3]);
                    *(u32x2*)(dstX + (size_t)row * D + 4 * lane + 256 * j) = ox;
                    const f32x4 a = y * scv[t][j] + shv[t][j];
                    *(unsigned*)(dstA8 + (size_t)row * D + 4 * lane + 256 * j) = cvt4_fp8(a[0], a[1], a[2], a[3]);
                }
            }
        }
    }
#undef LN_LOAD
}

__device__ __forceinline__ void phase_fin(const Params& p, int k, int nsplit, float accs, const int wv) {
    int tid_ = TIDX; asm volatile("" : "+v"(tid_)); const int tid = tid_, lane = tid & 63, w = __builtin_amdgcn_readfirstlane(tid >> 6);
    const int r = blockIdx.x * 8 + w; if (r >= MS) return;
    const int row = MP + r; const int bid = row_bid(row);
    const float* mod = (const float*)(p.ws + WS_MOD); const float* slab = (const float*)(p.ws + WS_SLAB);
    bf16_t* Xb = (bf16_t*)(p.ws + WS_X); bf16_t* A = (bf16_t*)(p.ws + WS_A);
    const float gs = ((k == 1) ? 1.0f : 0.5f) * accs;
    unsigned char* A8 = p.ws + WS_A8;
    const float* gate = mod + (size_t)bid * NMODC + (size_t)(3 * k + 2) * D; const float* modn = mod + (size_t)bid * NMODC + (size_t)(3 * (k + 1)) * D;
    const float* g = p.in[I_LNG] + k * D; const float* b = p.in[I_LNB] + k * D;
    f32x4 v[4]; float s = 0.f, s2 = 0.f;
#pragma unroll
    for (int j = 0; j < 4; ++j) {
        const int c = 4 * lane + 256 * j;
        f32x4 a = (f32x4){0.f, 0.f, 0.f, 0.f};
        for (int sidx = 0; sidx < nsplit; ++sidx) a += *(const f32x4*)(slab + ((size_t)sidx * 256 + r) * D + c);
        const u32x2 xr = *(const u32x2*)(Xb + (size_t)row * D + c);
        const f32x4 x = (f32x4){bf_lo(xr.x), bf_hi(xr.x), bf_lo(xr.y), bf_hi(xr.y)};
        const f32x4 g4 = *(const f32x4*)(gate + c);
        v[j] = x * ALPHA + (g4 + 1.0f) * gs * a;
        s += (v[j][0] + v[j][1]) + (v[j][2] + v[j][3]);
    }
    const float mean = wave_sum(s) * (1.0f / D);
#pragma unroll
    for (int j = 0; j < 4; ++j) { v[j] = v[j] - mean; s2 += (v[j][0] * v[j][0] + v[j][1] * v[j][1]) + (v[j][2] * v[j][2] + v[j][3] * v[j][3]); }
    const float rstd = rsqrtf(wave_sum(s2) * (1.0f / D) + LN_EPS);
#pragma unroll
    for (int j = 0; j < 4; ++j) {
        const int c = 4 * lane + 256 * j;
        const f32x4 y = v[j] * rstd * *(const f32x4*)(g + c) + *(const f32x4*)(b + c);
        if (k == 2) *(f32x4*)(p.out + O_Y + (size_t)row * D + c) = y;
        else {
            u32x2 ox; ox.x = cvt_pk_bf16(y[0], y[1]); ox.y = cvt_pk_bf16(y[2], y[3]); *(u32x2*)(Xb + (size_t)row * D + c) = ox;
            const f32x4 a = y * (*(const f32x4*)(modn + D + c) + 1.0f) + *(const f32x4*)(modn + c);
            if (k == 1) *(unsigned*)(A8 + (size_t)row * D + c) = cvt4_fp8(a[0], a[1], a[2], a[3]);
            else { u32x2 oa; oa.x = cvt_pk_bf16(a[0], a[1]); oa.y = cvt_pk_bf16(a[2], a[3]); *(u32x2*)(A + (size_t)row * D + c) = oa; }
        }
    }
}

__device__ __forceinline__ void phase_mixer1(const Params& p, LAS unsigned char* lds, const bool do_sg, const bool do_lru, const int wv) {
    int tid_ = TIDX; asm volatile("" : "+v"(tid_)); const int tid = tid_, lane = tid & 63, w = __builtin_amdgcn_readfirstlane(tid >> 6), fr = lane & 15, fq = lane >> 4;
    LAS unsigned char* vnT = lds;
    LAS float* stats = (LAS float*)(lds + 139264);
    LAS unsigned char* xscr = lds + 143360 + w * 2304;
    const bf16_t* P = (const bf16_t*)(p.ws + WS_P);
    bf16_t* Y = (bf16_t*)(p.ws + WS_Y);
    bf16_t* AC = (bf16_t*)(p.ws + WS_AC);
    const bf16_t* sgw = (const bf16_t*)(p.ws + WS_SGW);
    const bf16_t* lrub = (const bf16_t*)(p.ws + WS_LRUB);
    float* agg = (float*)(p.ws + WS_AGG);
    const int h = w, chD = 64 * h + 4 * fr;
    const f32x4 cw0 = *(const f32x4*)(p.in[I_CONVW] + 0 * 512 + chD), cw1 = *(const f32x4*)(p.in[I_CONVW] + 1 * 512 + chD);
    const f32x4 cw2 = *(const f32x4*)(p.in[I_CONVW] + 2 * 512 + chD), cw3 = *(const f32x4*)(p.in[I_CONVW] + 3 * 512 + chD);
    const f32x4 cb4 = *(const f32x4*)(p.in[I_CONVB] + chD), ba4 = *(const f32x4*)(p.in[I_LBA] + chD), bx4 = *(const f32x4*)(p.in[I_LBX] + chD);
    const f32x4 nba4 = ba4 * -1.4426950408889634f, nbx4 = bx4 * -1.4426950408889634f;
    f32x4 sp4; { const f32x4 lam = *(const f32x4*)(p.in[I_LLAM] + chD);
#pragma unroll
        for (int i = 0; i < 4; ++i) sp4[i] = 8.0f * 1.4426950408889634f * log1pf(expf(-lam[i])); }

    const bool sw16 = gather4_calibrate(fq);
    const int lane_outer = lane;
    for (int q = blockIdx.x; q < NCHUNK; q += gridDim.x) {
        int lane = lane_outer; asm volatile("" : "+v"(lane));
        const int fr = lane & 15, fq = lane >> 4;
        const bool smp = q >= 512;
        const int ntok = smp ? 32 : 128;
        const int row0 = smp ? MP + 32 * (q - 512) : q * 128;
        const int tseq0 = smp ? 0 : (q & 63) * 128;
        if (do_sg) {
            { LAS float* tb = (LAS float*)(lds + 143360); tb[tid] = p.in[I_SGLG][tid]; tb[512 + tid] = p.in[I_SGLB][tid]; }
            const int th = w & 1, g = w >> 1, j = 64 * th + lane;
            const bool valid = j < ntok;
            u32x4 raw[16];
            const bf16_t* src = P + (size_t)(row0 + (valid ? j : 0)) * DIN + 1536 + 128 * g;
            float s = 0.f, ss = 0.f;
#pragma unroll
            for (int c = 0; c < 16; ++c) {
                raw[c] = *(const u32x4*)(src + 8 * c);
#pragma unroll
                for (int e = 0; e < 4; ++e) { const float a = bf_lo(raw[c][e]), b = bf_hi(raw[c][e]); s += a + b; ss += a * a + b * b; }
            }
            stats[(j * 4 + g) * 2 + 0] = s; stats[(j * 4 + g) * 2 + 1] = ss;
            __syncthreads();
            float ts = 0.f, tss = 0.f;
#pragma unroll
            for (int gg = 0; gg < 4; ++gg) { ts += stats[(j * 4 + gg) * 2 + 0]; tss += stats[(j * 4 + gg) * 2 + 1]; }
            const float mean = ts * (1.0f / 512.0f), var = fmaxf(tss * (1.0f / 512.0f) - mean * mean, 0.f), rstd = rsqrtf(var + LN_EPS);
            const LAS float* lgT = (const LAS float*)(lds + 143360) + 128 * g; const LAS float* lbT = lgT + 512;
#pragma unroll
            for (int c = 0; c < 16; ++c) {
                const f32x4 ga = *(const LAS f32x4*)(lgT + 8 * c), gb = *(const LAS f32x4*)(lgT + 8 * c + 4), ba = *(const LAS f32x4*)(lbT + 8 * c), bb = *(const LAS f32x4*)(lbT + 8 * c + 4);
#pragma unroll
                for (int e = 0; e < 8; ++e) {
                    const unsigned u = raw[c][e >> 1]; const float x = (e & 1) ? bf_hi(u) : bf_lo(u);
                    const int dl = 8 * c + e;
                    float y = (x - mean) * rstd * (e < 4 ? ga[e] : gb[e - 4]) + (e < 4 ? ba[e] : bb[e - 4]);
                    if (!valid) y = 0.f;
                    *(LAS bf16_t*)(vnT + (128 * g + dl) * 272 + 2 * j) = (bf16_t)(cvt_pk_bf16(y, 0.f) & 0xffffu);
                }
            }
            if (smp) {
                float* ov = p.out + O_SGV + (size_t)((q - 512) * 32 + j) * 512 + 128 * g;
                if (valid) {
#pragma unroll
                    for (int c = 0; c < 16; ++c)
#pragma unroll
                        for (int e = 0; e < 8; ++e) {
                            const unsigned u = raw[c][e >> 1]; const float x = (e & 1) ? bf_hi(u) : bf_lo(u);
                            ov[8 * c + e] = (x - mean) * rstd * lgT[8 * c + e] + lbT[8 * c + e];
                        }
                }
            }
            __syncthreads();
        }
        if (do_sg) {
            const int g = w >> 1, hf = w & 1;
            const LAS unsigned char* afb = vnT + (128 * g + 64 * hf + 16 * (fr >> 2) + (fr & 3)) * 272 + 16 * fq;
            const int nib = ntok >> 4;
            const int chb = 128 * g + 64 * hf + 16 * fq;
            bf16x8 nBf[4]; u32x4 nu0, nu1; float nbias;
#define SG_LOAD(ib_) do { const bf16_t* wb_ = sgw + (size_t)(g * 128 + 16 * (ib_) + fr) * 128 + 8 * fq; \
                _Pragma("unroll") for (int ks = 0; ks < 4; ++ks) nBf[ks] = *(const bf16x8*)(wb_ + 32 * ks);     \
                const size_t row_ = (size_t)row0 + 16 * (ib_) + fr; nbias = p.in[I_SGB][g * 128 + 16 * (ib_) + fr]; \
                nu0 = *(const u32x4*)(P + row_ * DIN + 1024 + chb); nu1 = *(const u32x4*)(P + row_ * DIN + 1024 + chb + 8); } while (0)
            SG_LOAD(0);
            for (int ib = 0; ib < nib; ++ib) {
                f32x4 acc[4];
#pragma unroll
                for (int mb = 0; mb < 4; ++mb) acc[mb] = (f32x4){0.f, 0.f, 0.f, 0.f};
                bf16x8 Bf[4];
#pragma unroll
                for (int ks = 0; ks < 4; ++ks) Bf[ks] = nBf[ks];
                const u32x4 u0 = nu0, u1 = nu1; const float bias = nbias;
                if (ib + 1 < nib) SG_LOAD(ib + 1);
#pragma unroll
                for (int ks = 0; ks < 4; ++ks) {
#pragma unroll
                    for (int mb = 0; mb < 4; ++mb) acc[mb] = __builtin_amdgcn_mfma_f32_16x16x32_bf16(*(const LAS bf16x8*)(afb + mb * 4 * 272 + 64 * ks), Bf[ks], acc[mb], 0, 0, 0);
                }
                const int i = 16 * ib + fr; const size_t row = (size_t)row0 + i;
                float yv[16];
#pragma unroll
                for (int mb = 0; mb < 4; ++mb)
#pragma unroll
                    for (int r = 0; r < 4; ++r) {
                        const int e = mb * 4 + r; const unsigned uu = (e < 8) ? u0[e >> 1] : u1[(e - 8) >> 1];
                        const float us = (e & 1) ? bf_hi(uu) : bf_lo(uu);
                        yv[e] = us * (acc[mb][r] + bias);
                    }
                u32x4 o0, o1;
                o0.x = cvt_pk_bf16(yv[0], yv[1]); o0.y = cvt_pk_bf16(yv[2], yv[3]); o0.z = cvt_pk_bf16(yv[4], yv[5]); o0.w = cvt_pk_bf16(yv[6], yv[7]);
                o1.x = cvt_pk_bf16(yv[8], yv[9]); o1.y = cvt_pk_bf16(yv[10], yv[11]); o1.z = cvt_pk_bf16(yv[12], yv[13]); o1.w = cvt_pk_bf16(yv[14], yv[15]);
                *(u32x4*)(Y + row * D + 512 + chb) = o0; *(u32x4*)(Y + row * D + 512 + chb + 8) = o1;
            }
#undef SG_LOAD
        }
        if (do_lru) {
            float RA[4] = {1.f, 1.f, 1.f, 1.f}, RH[4] = {0.f, 0.f, 0.f, 0.f};
            const int nblk = ntok >> 4;
            const bool lastchunk = smp || ((q & 63) == 63);
            const int lane_q = lane;
            __syncthreads();
            LAS unsigned char* bwl = lds + w * 16384;
#pragma unroll
            for (int hb = 0; hb < 2; ++hb) {
                bf16x8 tb8[8];
#pragma unroll
                for (int i = 0; i < 8; ++i) tb8[i] = *(const bf16x8*)(lrub + ((size_t)(h * 16 + 8 * hb + i) * 64 + lane) * 8);
#pragma unroll
                for (int i = 0; i < 8; ++i) *(LAS bf16x8*)(bwl + (8 * hb + i) * 1024 + lane * 16) = tb8[i];
            }
            u32x2 nxa[7], nga[4];
            u32x2 hv[3];
#pragma unroll
            for (int i = 0; i < 3; ++i) { hv[i].x = 0u; hv[i].y = 0u; }
            if (smp) {
#pragma unroll
                for (int i = 0; i < 3; ++i) { const f32x4 f = *(const f32x4*)(p.in[I_SCONV] + (size_t)((q - 512) * 3 + i) * 512 + chD); hv[i].x = cvt_pk_bf16(f[0], f[1]); hv[i].y = cvt_pk_bf16(f[2], f[3]); }
            }
#define LRU_LOAD(tb_) do { _Pragma("unroll") for (int dr = 0; dr < 7; ++dr) { const int tk = (tb_) + 4 * fq - 3 + dr; const bool pre = (tseq0 + tk) < 0; \
        nxa[dr] = *(const u32x2*)(P + (size_t)(row0 + (pre ? 0 : tk)) * DIN + chD); }   \
        _Pragma("unroll") for (int r = 0; r < 4; ++r) nga[r] = *(const u32x2*)(P + (size_t)(row0 + (tb_) + 4 * fq + r) * DIN + 512 + chD); } while (0)
            LRU_LOAD(0);
            for (int blk = 0; blk < nblk; ++blk) {
                asm volatile("" ::: "memory");
                int lane = lane_q; asm volatile("" : "+v"(lane));
                const int fr = lane & 15, fq = lane >> 4;
                const int tb = 16 * blk;
                float xaf[7][4];
                u32x2 gau[4];
#pragma unroll
                for (int dr = 0; dr < 7; ++dr) {
                    const bool pre = (tseq0 + tb + 4 * fq - 3 + dr) < 0;
                    const unsigned ux = pre ? hv[dr < 3 ? dr : 0].x : nxa[dr].x, uy = pre ? hv[dr < 3 ? dr : 0].y : nxa[dr].y;
                    xaf[dr][0] = bf_lo(ux); xaf[dr][1] = bf_hi(ux); xaf[dr][2] = bf_lo(uy); xaf[dr][3] = bf_hi(uy); }
#pragma unroll
                for (int r = 0; r < 4; ++r) gau[r] = nga[r];
                if (blk + 1 < nblk) LRU_LOAD(tb + 16);
                if (lastchunk && blk == nblk - 1 && fq == 3) {
                    float* oc = smp ? p.out + O_CONVS + (size_t)(q - 512) * 1536 : p.out + O_CONVP + (size_t)(q >> 6) * 1536;
#pragma unroll
                    for (int r = 1; r < 4; ++r) *(f32x4*)(oc + (r - 1) * 512 + chD) = (f32x4){xaf[r + 3][0], xaf[r + 3][1], xaf[r + 3][2], xaf[r + 3][3]};
                }
                float xc[4][4];
#pragma unroll
                for (int r = 0; r < 4; ++r)
#pragma unroll
                    for (int nb = 0; nb < 4; ++nb)
                        xc[r][nb] = cb4[nb] + cw0[nb] * xaf[r][nb] + cw1[nb] * xaf[r + 1][nb] + cw2[nb] * xaf[r + 2][nb] + cw3[nb] * xaf[r + 3][nb];
#pragma unroll
                for (int r = 0; r < 4; ++r) { u32x2 o; o.x = cvt_pk_bf16(xc[r][0], xc[r][1]); o.y = cvt_pk_bf16(xc[r][2], xc[r][3]); *(LAS u32x2*)(xscr + (4 * fq + r) * 144 + 8 * fr) = o; }
                asm volatile("s_waitcnt lgkmcnt(0)" ::: "memory");
                const bf16x8 a0 = *(const LAS bf16x8*)(xscr + fr * 144 + 16 * fq), a1 = *(const LAS bf16x8*)(xscr + fr * 144 + 64 + 16 * fq);
                unsigned y0p[4][2], y1p[4][2];
#pragma unroll
                for (int nbp = 0; nbp < 2; ++nbp) {
                    float y0v[2][4], y1v[2][4];
#pragma unroll
                    for (int nbi = 0; nbi < 2; ++nbi) {
                        const int nb = 2 * nbp + nbi;
                        const bf16x8 b0 = *(const LAS bf16x8*)(bwl + ((0 * 4 + nb) * 2 + 0) * 1024 + lane * 16), b1 = *(const LAS bf16x8*)(bwl + ((0 * 4 + nb) * 2 + 1) * 1024 + lane * 16);
                        const bf16x8 c0 = *(const LAS bf16x8*)(bwl + ((1 * 4 + nb) * 2 + 0) * 1024 + lane * 16), c1 = *(const LAS bf16x8*)(bwl + ((1 * 4 + nb) * 2 + 1) * 1024 + lane * 16);
                        const f32x4 z = (f32x4){0.f, 0.f, 0.f, 0.f};
                        f32x4 racc = __builtin_amdgcn_mfma_f32_16x16x32_bf16(a0, b0, z, 0, 0, 0);
                        racc = __builtin_amdgcn_mfma_f32_16x16x32_bf16(a1, b1, racc, 0, 0, 0);
                        f32x4 iacc = __builtin_amdgcn_mfma_f32_16x16x32_bf16(a0, c0, z, 0, 0, 0);
                        iacc = __builtin_amdgcn_mfma_f32_16x16x32_bf16(a1, c1, iacc, 0, 0, 0);
                        float Ac[4], Hc[4]; float ca = 1.f, ch = 0.f;
#pragma unroll
                        for (int r = 0; r < 4; ++r) {
                            const float rg = __builtin_amdgcn_rcpf(1.0f + fexp2(racc[r] * -1.4426950408889634f + nba4[nb])), ig = __builtin_amdgcn_rcpf(1.0f + fexp2(iacc[r] * -1.4426950408889634f + nbx4[nb]));
                            const float a = fexp2(-sp4[nb] * rg);
                            const float mult = __builtin_amdgcn_sqrtf(__builtin_fmaf(-a, a, 1.0f));
                            const float u = mult * (ig * xc[r][nb]);
                            ca *= a; ch = a * ch + u; Ac[r] = ca; Hc[r] = ch;
                        }
                        const float tA = Ac[3], tH = Hc[3];
                        float A0, A1, A2, A3, H0, H1, H2, H3;
                        gather4(tA, sw16, A0, A1, A2, A3); gather4(tH, sw16, H0, H1, H2, H3);
                        const float pa0 = RA[nb], ph0 = RH[nb];
                        const float pa1 = pa0 * A0, ph1 = A0 * ph0 + H0;
                        const float pa2 = pa1 * A1, ph2 = A1 * ph1 + H1;
                        const float pa3 = pa2 * A2, ph3 = A2 * ph2 + H2;
                        RA[nb] = pa3 * A3; RH[nb] = A3 * ph3 + H3;
                        const float PA = fq == 0 ? pa0 : fq == 1 ? pa1 : fq == 2 ? pa2 : pa3, PH = fq == 0 ? ph0 : fq == 1 ? ph1 : fq == 2 ? ph2 : ph3;
#pragma unroll
                        for (int r = 0; r < 4; ++r) {
                            const unsigned gu = (nb < 2) ? gau[r].x : gau[r].y; const float gav = (nb & 1) ? bf_hi(gu) : bf_lo(gu);
                            const float G = gelu_tanh(gav);
                            y0v[nbi][r] = (Hc[r] + Ac[r] * PH) * G; y1v[nbi][r] = (PA * Ac[r]) * G;
                        }
                    }
#pragma unroll
                    for (int r = 0; r < 4; ++r) { y0p[r][nbp] = cvt_pk_bf16(y0v[0][r], y0v[1][r]); y1p[r][nbp] = cvt_pk_bf16(y1v[0][r], y1v[1][r]); }
                }
#pragma unroll
                for (int r = 0; r < 4; ++r) {
                    const size_t row = (size_t)row0 + tb + 4 * fq + r;
                    u32x2 o; o.x = y0p[r][0]; o.y = y0p[r][1]; *(u32x2*)(Y + row * D + chD) = o;
                    u32x2 o2; o2.x = y1p[r][0]; o2.y = y1p[r][1]; *(u32x2*)(AC + row * 512 + chD) = o2;
                }
            }
            if (fq == 0) {
                *(f32x4*)(agg + (size_t)(q * 2 + 0) * 512 + chD) = (f32x4){RA[0], RA[1], RA[2], RA[3]};
                *(f32x4*)(agg + (size_t)(q * 2 + 1) * 512 + chD) = (f32x4){RH[0], RH[1], RH[2], RH[3]};
            }
        }
        __syncthreads();
    }
}

__device__ __forceinline__ void phase_mixer2(const Params& p, LAS unsigned char* lds, const int wv) {
    int tid_ = TIDX; asm volatile("" : "+v"(tid_)); const int tid = tid_;
    LAS float* carryL = (LAS float*)lds;
    bf16_t* Y = (bf16_t*)(p.ws + WS_Y);
    const bf16_t* AC = (const bf16_t*)(p.ws + WS_AC);
    const float* agg = (const float*)(p.ws + WS_AGG);
    for (int q = blockIdx.x; q < NCHUNK; q += gridDim.x) {
        const bool smp = q >= 512;
        const int ntok = smp ? 32 : 128;
        const int row0 = smp ? MP + 32 * (q - 512) : q * 128;
        float carry;
        if (!smp) {
            const int qb = q & ~63, jc = q & 63; carry = 0.f;
            for (int i0 = 0; i0 < jc; i0 += 8) {
                float Ab[8], Hb[8];
#pragma unroll
                for (int i = 0; i < 8; ++i) { const int qi = qb + ((i0 + i < jc) ? i0 + i : 0); Ab[i] = agg[(size_t)(qi * 2) * 512 + tid]; Hb[i] = agg[(size_t)(qi * 2 + 1) * 512 + tid]; }
#pragma unroll
                for (int i = 0; i < 8; ++i) { const bool on = i0 + i < jc; carry = (on ? Ab[i] : 1.0f) * carry + (on ? Hb[i] : 0.0f); }
            }
        } else carry = p.in[I_SLRU][(q - 512) * 512 + tid];
        if (smp || (q & 63) == 63) {
            const float A = agg[(size_t)(q * 2) * 512 + tid], Hh = agg[(size_t)(q * 2 + 1) * 512 + tid];
            float* dst = smp ? p.out + O_LRUS + (size_t)(q - 512) * 512 : p.out + O_LRUP + (size_t)(q >> 6) * 512;
            dst[tid] = A * carry + Hh;
        }
        carryL[tid] = carry;
        __syncthreads();
        const int c8 = (tid & 63) * 8, rs = tid >> 6;
        float cr[8];
#pragma unroll
        for (int e = 0; e < 8; ++e) cr[e] = carryL[c8 + e];
        for (int r0 = rs; r0 < ntok; r0 += 32) {
            u32x4 a[4], b[4];
#pragma unroll
            for (int i = 0; i < 4; ++i) { const size_t row = (size_t)row0 + r0 + 8 * i; a[i] = *(const u32x4*)(Y + row * D + c8); b[i] = *(const u32x4*)(AC + row * 512 + c8); }
#pragma unroll
            for (int i = 0; i < 4; ++i) {
                const size_t row = (size_t)row0 + r0 + 8 * i; u32x4 o;
#pragma unroll
                for (int e = 0; e < 4; ++e) o[e] = cvt_pk_bf16(bf_lo(a[i][e]) + bf_lo(b[i][e]) * cr[2 * e], bf_hi(a[i][e]) + bf_hi(b[i][e]) * cr[2 * e + 1]);
                *(u32x4*)(Y + row * D + c8) = o;
            }
        }
        __syncthreads();
    }
}

__global__ __launch_bounds__(512, 2) void mega(Params p) {
    extern __shared__ __attribute__((aligned(16))) unsigned char smem[];
    LAS unsigned char* lds = (LAS unsigned char*)smem;
    const int wv = __builtin_amdgcn_readfirstlane((int)(__builtin_amdgcn_workitem_id_x() >> 6));
    cg::grid_group grid = cg::this_grid();
    const float* mod = (const float*)(p.ws + WS_MOD);
    bf16_t* Xb = (bf16_t*)(p.ws + WS_X);
    bf16_t* A = (bf16_t*)(p.ws + WS_A);
    bf16_t* Yb = (bf16_t*)(p.ws + WS_Y);
    unsigned char* H8 = p.ws + WS_H;
    unsigned char* A8 = p.ws + WS_A8;
    bf16_t* Pb = (bf16_t*)(p.ws + WS_P);
    unsigned* barw = (unsigned*)(p.ws + WS_BAR);
    volatile LAS unsigned* bst = (volatile LAS unsigned*)(lds + 161792);
    if (p.nprog < 0) grid.sync();
    if (TIDX == 0) { bst[0] = 0u; bst[1] = 0u; }
    __syncthreads();
    (void)xcd_barrier_post(barw, bst, wv);
    for (int pi = 0; pi < p.nprog; ++pi) {
        const int ph = p.prog[pi];
        switch (ph) {
        #ifndef NO_PREP
        case PH_PREP: phase_prep(p, lds, wv); break;
#endif
        case PH_MOD: phase_mod(p, wv); break;
        case PH_F2: phase_fin(p, 0, 11, 1.0f / (SC_H * SC_W2), wv); break;
        case PH_F4: phase_fin(p, 1, 4, 1.0f, wv); break;
        case PH_F6: phase_fin(p, 2, 11, 1.0f / (SC_H * SC_W2), wv); break;
        case PH_LN0: ln_pass(p.in[I_XP], p.in[I_XS], Xb, A8, p.in[I_LNIG], p.in[I_LNIB], mod, 0, wv); break;
#ifndef NO_G1
        case PH_G1: case PH_G5: {
            pg8::Gemm g{(const bf16_t*)A8, (const bf16_t*)(p.ws + (ph == PH_G1 ? WS_W13A : WS_W13B)), MT, 2 * FF, D / 2};
            pg8::StaticOrder S; S.init(MT, 2 * FF, D / 2, gridDim.x, blockIdx.x);
            pg8::EpiSwiglu E{H8, 1.0f / SC_W13};
            pg8::gemm_phase<true>(lds, g, S, E, wv);
        } break;
#endif
#ifndef NO_G2
        case PH_G2: case PH_G6: {
            pg8::Gemm g{(const bf16_t*)H8, (const bf16_t*)(p.ws + (ph == PH_G2 ? WS_W2A : WS_W2B)), MT, D, FF / 2};
            pg8::PanelOrder S; S.init(FF / 2, gridDim.x, blockIdx.x);
            const int k = ph == PH_G2 ? 0 : 2;
            pg8::EpiResLn E{Xb, ph == PH_G6 ? p.out + O_Y : nullptr, A, nullptr, mod + (size_t)(3 * k + 2) * D, mod + (size_t)(3 * (k + 1)) * D,
                            p.in[I_LNG] + k * D, p.in[I_LNB] + k * D, 0.5f / (SC_H * SC_W2),
                            (unsigned long long*)(p.ws + WS_XBUF), (unsigned*)(p.ws + WS_CNT), ph == PH_G2 ? 32u : 96u};
            pg8::gemm_phase<true>(lds, g, S, E, wv);
            pg8::SubOrder S2; S2.init(FF / 128, 2, gridDim.x, blockIdx.x);
            pg8::EpiSlab E2{(float*)(p.ws + WS_SLAB)};
            pg8::gemm_phase<true>(lds, g, S2, E2, wv);
        } break;
        case PH_G4: {
            pg8::Gemm g{Yb, (const bf16_t*)(p.ws + WS_WOUT), MT, D, D};
            pg8::PanelOrder S; S.init(D, gridDim.x, blockIdx.x);
            pg8::EpiResLn E{Xb, nullptr, nullptr, A8, mod + (size_t)5 * D, mod + (size_t)6 * D, p.in[I_LNG] + D, p.in[I_LNB] + D, 1.0f,
                            (unsigned long long*)(p.ws + WS_XBUF), (unsigned*)(p.ws + WS_CNT), 64u};
            pg8::gemm_phase<false>(lds, g, S, E, wv);
            pg8::SubOrder S2; S2.init(D / 64, 4, gridDim.x, blockIdx.x);
            pg8::EpiSlab E2{(float*)(p.ws + WS_SLAB)};
            pg8::gemm_phase<false>(lds, g, S2, E2, wv);
        } break;
#endif
#ifndef NO_G3
        case PH_G3: {
            pg8::Gemm g{A, (const bf16_t*)(p.ws + WS_WIN), MT, DIN, D};
            pg8::StaticOrder S; S.init(MT, DIN, D, gridDim.x, blockIdx.x);
            pg8::EpiP E{Pb, DIN};
            pg8::gemm_phase<false>(lds, g, S, E, wv);
        } break;
#endif
        #ifndef NO_M1
        case PH_M1: case PH_M1S: case PH_M1L: phase_mixer1(p, lds, ph != PH_M1L, ph != PH_M1S, wv); break;
#endif
        #ifndef NO_M2
        case PH_M2: phase_mixer2(p, lds, wv); break;
#endif
        default: break;
        }
        if (pi + 1 < p.nprog) xcd_barrier(barw, (volatile LAS unsigned*)(lds + 161792), wv);
    }
}

extern "C" void kernel_launch(void* const* d_in, const int* in_sizes, int n_in, void* d_out, int out_size, void* d_ws, size_t ws_size, hipStream_t stream) {
    static int grid_blocks = 0;
    if (grid_blocks == 0) {
        if (n_in != 31 || ws_size < WS_END) { fprintf(stderr, "kernel_launch: unexpected n_in %d or ws_size %zu (< %zu)\n", n_in, ws_size, (size_t)WS_END); grid_blocks = -1; return; }
        int dev = 0, cus = 0, per_cu = 0;
        hipGetDevice(&dev);
        hipDeviceGetAttribute(&cus, hipDeviceAttributeMultiprocessorCount, dev);
        if (hipFuncSetAttribute((const void*)mega, hipFuncAttributeMaxDynamicSharedMemorySize, LDS_BYTES) != hipSuccess) { fprintf(stderr, "kernel_launch: hipFuncSetAttribute failed\n"); grid_blocks = -1; return; }
        hipOccupancyMaxActiveBlocksPerMultiprocessor(&per_cu, (const void*)mega, 512, LDS_BYTES);
        if (per_cu < 1) { fprintf(stderr, "kernel_launch: occupancy query says %d blocks per CU\n", per_cu); per_cu = 1; }
        (void)hipGetLastError();
        grid_blocks = cus * per_cu;
    }
    if (grid_blocks < 0) return;
    Params p{};
    for (int i = 0; i < 31; ++i) p.in[i] = (const float*)d_in[i];
    p.out = (float*)d_out; p.ws = (unsigned char*)d_ws;
#ifndef PROG
#define PROG PH_PREP, PH_LN0, PH_G1, PH_G2, PH_F2, PH_G3, PH_M1, PH_M2, PH_G4, PH_F4, PH_G5, PH_G6, PH_F6
#endif
    { const int prog[] = {PROG}; p.nprog = (int)(sizeof(prog) / sizeof(int)); for (int i = 0; i < p.nprog; ++i) p.prog[i] = prog[i]; }
    if (hipMemsetAsync((char*)d_ws + WS_BAR, 0, WS_ZERO_END - WS_BAR, stream) != hipSuccess) { fprintf(stderr, "kernel_launch: hipMemsetAsync failed\n"); return; }
    void* args[] = {&p};
    hipError_t e = hipLaunchCooperativeKernel((const void*)mega, dim3(grid_blocks), dim3(512), args, LDS_BYTES, stream);
    if (e != hipSuccess) fprintf(stderr, "cooperative launch failed: %s (grid %d)\n", hipGetErrorString(e), grid_blocks);
}
```
